# Optimizing an MI355X kernel written in HIP

```python
import jax, jax.numpy as jnp
from jax import lax
import numpy as np

D_MODEL = 2048
BATCH = 4
SEQ = 2048
DEPTH = 2
DEC_BATCH = 128
DEC_SEQ = 4
PAST_LEN = 16384
PAGE_SIZE = 128

N_HEADS = 4
HEAD_K = 128
HEAD_V = 256
MIX_K = N_HEADS * HEAD_K
MIX_V = N_HEADS * HEAD_V
N_BRANCH = 3
GLA_RANK = 16
GLA_TEMP = 16.0
D_FF = 5632
CONV_W = 3
CHUNK = 64
ROPE_BASE = 10000.0
EPS = 1e-6
IN_SIZES = (MIX_K, MIX_K, MIX_V, MIX_V,
            MIX_K, MIX_K, MIX_V, MIX_V, GLA_RANK,
            MIX_K, MIX_K, MIX_V, MIX_V,
            N_BRANCH * D_MODEL)
N_IN = sum(IN_SIZES)

kernel_name = 'hybrid_ret_gla_hgrn2_convffn_step'


def rmsnorm(x, w):
    xf = x.astype(jnp.float32)
    y = xf * lax.rsqrt(jnp.mean(xf * xf, axis=-1, keepdims=True) + EPS)
    return (y * w.astype(jnp.float32)).astype(x.dtype)


def head_rmsnorm(o, w):
    return o * lax.rsqrt(jnp.mean(o * o, axis=-1, keepdims=True) + EPS) * w.astype(jnp.float32)


def rope(x, pos):
    half = x.shape[-1] // 2
    inv = ROPE_BASE ** (-jnp.arange(half, dtype=jnp.float32) / half)
    ang = pos[:, None] * inv[None, :]
    cos = jnp.cos(ang)[None, :, None, :]
    sin = jnp.sin(ang)[None, :, None, :]
    x1, x2 = x[..., :half], x[..., half:]
    return jnp.concatenate([x1 * cos - x2 * sin, x1 * sin + x2 * cos], axis=-1)


def chunked_recurrence(q, k, v, log_f, s0):
    B, T, H, K = q.shape
    V = v.shape[-1]
    c = min(CHUNK, T)
    n = -(-T // c)
    pad = n * c - T
    if pad:
        pw = ((0, 0), (0, pad), (0, 0), (0, 0))
        q, k, v, log_f = (jnp.pad(a, pw) for a in (q, k, v, log_f))

    def chunks(a):
        return a.reshape(B, n, c, H, a.shape[-1]).transpose(1, 0, 2, 3, 4)

    causal = jnp.tril(jnp.ones((c, c), dtype=bool))[None, :, :, None, None]

    def step(S, inp):
        qc, kc, vc, gc = inp
        b = jnp.cumsum(gc, axis=1)
        b_last = b[:, -1]
        o_inter = jnp.einsum('bthk,bhkv->bthv', qc * jnp.exp(b), S)
        diff = jnp.where(causal, b[:, :, None] - b[:, None, :], 0.0)
        decay = jnp.where(causal, jnp.exp(diff), 0.0)
        scores = jnp.einsum('bthk,bshk,btshk->btsh', qc, kc, decay)
        o_intra = jnp.einsum('btsh,bshv->bthv', scores, vc)
        S_new = jnp.exp(b_last)[..., None] * S + jnp.einsum(
            'bshk,bshv->bhkv', kc * jnp.exp(b_last[:, None] - b), vc)
        return S_new, o_inter + o_intra

    S_fin, o = lax.scan(step, s0, tuple(chunks(a) for a in (q, k, v, log_f)))
    o = o.transpose(1, 0, 2, 3, 4).reshape(B, n * c, H, V)[:, :T]
    return o, S_fin


def mixer_branches(h, pos, s_ret, s_gla, s_hgrn, w_in, gla_w_lr, gla_b_lr, lb, head_norm, w_branch, w_out):
    B, T, _ = h.shape
    f32 = jnp.float32
    parts = jnp.split(h @ w_in, np.cumsum(IN_SIZES)[:-1].tolist(), axis=-1)
    (rq, rk, rv, rg, gq, gk, gv, gg, glr, hq, hf, hi, hg, mg) = parts

    def heads(a):
        return a.astype(f32).reshape(B, T, N_HEADS, -1)

    q_r = rope(heads(rq), pos)
    k_r = rope(heads(rk), pos) * (HEAD_K ** -0.5)
    log_gamma = jnp.log1p(-jnp.exp2(-5.0 - jnp.arange(N_HEADS, dtype=f32)))
    g_r = jnp.broadcast_to(log_gamma[None, None, :, None], q_r.shape)
    o_r, s_ret_new = chunked_recurrence(q_r, k_r, heads(rv), g_r, s_ret.astype(f32))

    log_a = jax.nn.log_sigmoid((glr @ gla_w_lr + gla_b_lr).astype(f32)) / GLA_TEMP
    o_g, s_gla_new = chunked_recurrence(heads(gq) * (HEAD_K ** -0.5), heads(gk), heads(gv),
                                        heads(log_a), s_gla.astype(f32))

    z = heads(hf)
    lbh = lb.astype(f32).reshape(N_HEADS, HEAD_K)
    f_h = lbh + (1.0 - lbh) * jax.nn.sigmoid(z)
    log_f = jnp.log(f_h)
    k_h = (1.0 - lbh) * jax.nn.sigmoid(-z)
    o_h, s_hgrn_new = chunked_recurrence(jax.nn.silu(heads(hq)), k_h, heads(hi), log_f, s_hgrn.astype(f32))

    gates = jax.nn.sigmoid(mg.astype(f32)).reshape(B, T, N_BRANCH, D_MODEL)
    branch_out = []
    for n_b, (o, g) in enumerate(((o_r, rg), (o_g, gg), (o_h, hg))):
        o = head_rmsnorm(o, head_norm[n_b]).reshape(B, T, MIX_V) * jax.nn.silu(g.astype(f32))
        branch_out.append(gates[:, :, n_b] * (o.astype(h.dtype) @ w_branch[n_b]).astype(f32))
    merged = (branch_out[0] + branch_out[1] + branch_out[2]).astype(h.dtype)
    return merged @ w_out, s_ret_new, s_gla_new, s_hgrn_new


def conv_ffn(h, buf, w_up, conv_w, conv_b, w_down):
    T = h.shape[1]
    u = h @ w_up
    full = jnp.concatenate([buf.astype(u.dtype), u], axis=1)
    conv = conv_b + conv_w[0] * full[:, 0:T]
    for j in range(1, CONV_W):
        conv = conv + conv_w[j] * full[:, j:j + T]
    a, b = jnp.split(conv, 2, axis=-1)
    return (jax.nn.silu(a) * b) @ w_down, full[:, -(CONV_W - 1):]


def trunk(x, c, pos0, s_ret, s_gla, s_hgrn, s_conv, w_in, gla_w_lr, gla_b_lr, hgrn_lb_logits,
          head_norm, w_branch, w_out, norm_mix, norm_ffn, w_ada, b_ada,
          ffn_w_up, ffn_conv_w, ffn_conv_b, ffn_w_down, final_norm):
    T = x.shape[1]
    pos = pos0 + jnp.arange(T, dtype=jnp.float32)
    sm = jax.nn.softmax(hgrn_lb_logits.astype(jnp.float32), axis=0)
    lbs = jnp.cumsum(sm, axis=0) - sm[0]
    new_ret, new_gla, new_hgrn, new_conv = [], [], [], []
    for l in range(DEPTH):
        mod = (jax.nn.silu(c) @ w_ada[l] + b_ada[l])[:, None, :]
        sh1, sc1, g1, sh2, sc2, g2 = jnp.split(mod, 6, axis=-1)
        h = rmsnorm(x, norm_mix[l]) * (1 + sc1) + sh1
        m, sr, sg, sh = mixer_branches(h, pos, s_ret[l], s_gla[l], s_hgrn[l], w_in[l], gla_w_lr[l],
                                       gla_b_lr[l], lbs[l], head_norm[l], w_branch[l], w_out[l])
        x = x + g1 * m
        h = rmsnorm(x, norm_ffn[l]) * (1 + sc2) + sh2
        f, sc = conv_ffn(h, s_conv[l], ffn_w_up[l], ffn_conv_w[l], ffn_conv_b[l], ffn_w_down[l])
        x = x + g2 * f
        new_ret.append(sr.astype(s_ret.dtype))
        new_gla.append(sg.astype(s_gla.dtype))
        new_hgrn.append(sh.astype(s_hgrn.dtype))
        new_conv.append(sc.astype(s_conv.dtype))
    y = rmsnorm(x, final_norm)
    return y, jnp.stack(new_ret), jnp.stack(new_gla), jnp.stack(new_hgrn), jnp.stack(new_conv)


def setup_inputs(seed: int = 0) -> dict:
    key = jax.random.key(seed)
    ks = jax.random.split(key, 28)
    f32 = jnp.float32

    def nrm(k, shape, s):
        return s * jax.random.normal(k, shape, f32)

    st_shape = (DEPTH, DEC_BATCH, N_HEADS, HEAD_K, HEAD_V)
    return {
        'x_prompt': nrm(ks[0], (BATCH, SEQ, D_MODEL), 1.0),
        'x_sample': nrm(ks[1], (DEC_BATCH, DEC_SEQ, D_MODEL), 1.0),
        'c_prompt': nrm(ks[2], (BATCH, D_MODEL), 1.0),
        'c_sample': nrm(ks[3], (DEC_BATCH, D_MODEL), 1.0),
        'state_ret': nrm(ks[4], st_shape, 0.5),
        'state_gla': nrm(ks[5], st_shape, 0.5),
        'state_hgrn': nrm(ks[6], st_shape, 0.5),
        'state_conv': nrm(ks[7], (DEPTH, DEC_BATCH, CONV_W - 1, 2 * D_FF), 1.0),
        'w_in': nrm(ks[8], (DEPTH, D_MODEL, N_IN), D_MODEL ** -0.5),
        'gla_w_lr': nrm(ks[9], (DEPTH, GLA_RANK, MIX_K), GLA_RANK ** -0.5),
        'gla_b_lr': nrm(ks[10], (DEPTH, MIX_K), 0.01),
        'hgrn_lb_logits': nrm(ks[11], (DEPTH, MIX_K), 1.0),
        'head_norm': 1.0 + nrm(ks[12], (DEPTH, N_BRANCH, HEAD_V), 0.01),
        'w_branch': nrm(ks[13], (DEPTH, N_BRANCH, MIX_V, D_MODEL), MIX_V ** -0.5),
        'w_out': nrm(ks[14], (DEPTH, D_MODEL, D_MODEL), D_MODEL ** -0.5),
        'norm_mix': 1.0 + nrm(ks[15], (DEPTH, D_MODEL), 0.01),
        'norm_ffn': 1.0 + nrm(ks[16], (DEPTH, D_MODEL), 0.01),
        'w_ada': nrm(ks[17], (DEPTH, D_MODEL, 6 * D_MODEL), 0.5 * D_MODEL ** -0.5),
        'b_ada': nrm(ks[18], (DEPTH, 6 * D_MODEL), 0.01),
        'ffn_w_up': nrm(ks[19], (DEPTH, D_MODEL, 2 * D_FF), D_MODEL ** -0.5),
        'ffn_conv_w': nrm(ks[20], (DEPTH, CONV_W, 2 * D_FF), CONV_W ** -0.5),
        'ffn_conv_b': nrm(ks[21], (DEPTH, 2 * D_FF), 0.01),
        'ffn_w_down': nrm(ks[22], (DEPTH, D_FF, D_MODEL), D_FF ** -0.5),
        'final_norm': 1.0 + nrm(ks[23], (D_MODEL,), 0.01),
    }


def reference(x_prompt, x_sample, c_prompt, c_sample, state_ret, state_gla, state_hgrn, state_conv,
              w_in, gla_w_lr, gla_b_lr, hgrn_lb_logits, head_norm, w_branch, w_out, norm_mix, norm_ffn,
              w_ada, b_ada, ffn_w_up, ffn_conv_w, ffn_conv_b, ffn_w_down, final_norm):
    weights = (w_in, gla_w_lr, gla_b_lr, hgrn_lb_logits, head_norm, w_branch, w_out, norm_mix, norm_ffn,
               w_ada, b_ada, ffn_w_up, ffn_conv_w, ffn_conv_b, ffn_w_down, final_norm)
    b = x_prompt.shape[0]
    z_st = jnp.zeros((DEPTH, b, N_HEADS, HEAD_K, HEAD_V), x_prompt.dtype)
    z_cv = jnp.zeros((DEPTH, b, CONV_W - 1, 2 * D_FF), x_prompt.dtype)
    y_prompt, p_ret, p_gla, p_hgrn, p_conv = trunk(x_prompt, c_prompt, 0, z_st, z_st, z_st, z_cv, *weights)
    y_sample, s_ret, s_gla, s_hgrn, s_conv = trunk(x_sample, c_sample, PAST_LEN, state_ret, state_gla,
                                                   state_hgrn, state_conv, *weights)
    return (y_prompt, y_sample, p_ret, p_gla, p_hgrn, p_conv, s_ret, s_gla, s_hgrn, s_conv)
```

```cpp
#include <hip/hip_runtime.h>
#include <cstdio>
#include <cstdint>
#ifndef REPMASK
#define REPMASK 0
#endif
#define NREP(b) (((REPMASK >> (b)) & 1) ? 2 : 1)
namespace pg8 {
#define PG8_LAS __attribute__((address_space(3)))
typedef unsigned short bf16_t;
typedef short bf16x8 __attribute__((ext_vector_type(8)));
typedef float f32x4 __attribute__((ext_vector_type(4)));
typedef unsigned u32x4 __attribute__((ext_vector_type(4)));
constexpr int BM = 256, BK = 64, HALF = 128, HTB = HALF * BK * 2  , STAGE_BYTES = 8 * HTB, NXCD = 8, WGM = 8;

__host__ __device__ __forceinline__ int lds_byte(int r, int c) { const int st = (r >> 4) * 2 + (c >> 5), rr = r & 15, cc = c & 31, ob = rr * 64 + cc * 2; return st * 1024 + (ob ^ (((ob >> 9) & 1) << 5)); }
__host__ __device__ __forceinline__ void stage_rc(int b, int& R, int& C) { const int st = b / 1024, sb = b % 1024, swz = sb ^ (((sb >> 9) & 1) << 5); R = (st >> 1) * 16 + swz / 64; C = (st & 1) * 32 + (swz % 64) / 2; }
__host__ __device__ __forceinline__ int perm32(int rho) { const int n = rho >> 4, i = rho & 15; return 8 * (i >> 2) + 4 * n + (i & 3); }

struct Unit { int pm, pn, seg; };
struct Gemm { const bf16_t* A; const bf16_t* Bt; int M, N, K; size_t a_seg, b_seg; };

struct StaticOrder {
    int nM, nN, nwg, G, c;
    __host__ __device__ __forceinline__ void init(int M, int N, int G_, int c_) { nM = M / BM; nN = N / BM; nwg = nM * nN; G = G_; c = c_; }
    __host__ __device__ __forceinline__ bool next(int i, Unit& u) const {
        const long L = (long)i * G + c; if (L >= nwg) return false;
        int wgid = (int)L; { const int q = nwg / NXCD, r = nwg % NXCD, xcd = wgid % NXCD, off = wgid / NXCD; wgid = (xcd < r ? xcd * (q + 1) : r * (q + 1) + (xcd - r) * q) + off; }
        const int nig = WGM * nN, gid = wgid / nig, fm = gid * WGM, gsz = (nM - fm) < WGM ? (nM - fm) : WGM;
        u.pm = fm + ((wgid % nig) % gsz); u.pn = (wgid % nig) / gsz; u.seg = 0; return true;
    }
    __device__ __forceinline__ void a_ready(const Unit&) const {}
    __device__ __forceinline__ void done(const Unit&) const {}
};

__device__ __forceinline__ unsigned cvt_pk_bf16(float lo, float hi) { unsigned r; asm volatile("v_cvt_pk_bf16_f32 %0, %1, %2" : "=v"(r) : "v"(lo), "v"(hi)); return r; }
typedef float f32x2 __attribute__((ext_vector_type(2)));
typedef unsigned u32x2 __attribute__((ext_vector_type(2)));
__device__ __forceinline__ float fast_sigmoid(float x) { return __builtin_amdgcn_rcpf(1.0f + __builtin_amdgcn_exp2f(-1.44269504f * x)); }
__device__ __forceinline__ float bf_lo(unsigned u) { return __uint_as_float(u << 16); }
__device__ __forceinline__ float bf_hi(unsigned u) { return __uint_as_float(u & 0xffff0000u); }

struct EpiBf16 {
    static constexpr bool PERM = true, AFTER_DRAIN = false, MULTISEG = false, AROWPERM = false;
    bf16_t* O; int ldc;
    __device__ __forceinline__ void operator()(const f32x4 (&acc)[2][2][4][2], const Unit& u, int wr, int wc, int fr, int fq) const {
        const int row0 = u.pm * BM + wr * 64 + fr, col0 = u.pn * BM + wc * 32 + 8 * fq;
#pragma unroll
        for (int ai = 0; ai < 2; ++ai)
#pragma unroll
            for (int m = 0; m < 4; ++m) { bf16_t* rowp = O + (size_t)(row0 + ai * HALF + m * 16) * ldc + col0;
#pragma unroll
                for (int bj = 0; bj < 2; ++bj) { const f32x4 v0 = acc[ai][bj][m][0], v1 = acc[ai][bj][m][1];
                    u32x4 w; w.x = cvt_pk_bf16(v0[0], v0[1]); w.y = cvt_pk_bf16(v0[2], v0[3]); w.z = cvt_pk_bf16(v1[0], v1[1]); w.w = cvt_pk_bf16(v1[2], v1[3]);
                    *(u32x4*)(rowp + bj * HALF) = w; } }
    }
};
struct EpiBranch {
    static constexpr bool PERM = false, AFTER_DRAIN = false, MULTISEG = false, AROWPERM = false;
    const bf16_t* gate; int ldg; float* mf; bf16_t* mb; int mode;
    __device__ __forceinline__ void operator()(const f32x4 (&acc)[2][2][4][2], const Unit& u, int wr, int wc, int fr, int fq) const {
        const int row0 = u.pm * BM + wr * 64 + fr, col0 = u.pn * BM + wc * 32 + 4 * fq;
#pragma unroll
        for (int ai = 0; ai < 2; ++ai)
#pragma unroll
            for (int m = 0; m < 4; ++m) { const int r = row0 + ai * HALF + m * 16;
#pragma unroll
                for (int bj = 0; bj < 2; ++bj)
#pragma unroll
                    for (int n = 0; n < 2; ++n) { const int c = col0 + bj * HALF + n * 16;
                        const u32x2 g2 = *(const u32x2*)(gate + (size_t)r * ldg + c);
                        f32x4 v = acc[ai][bj][m][n];
                        v[0] *= fast_sigmoid(bf_lo(g2.x)); v[1] *= fast_sigmoid(bf_hi(g2.x)); v[2] *= fast_sigmoid(bf_lo(g2.y)); v[3] *= fast_sigmoid(bf_hi(g2.y));
                        float* mp = mf + (size_t)r * 2048 + c;
                        if (mode == 0) { *(f32x4*)mp = v; }
                        else { v += *(const f32x4*)mp;
                            if (mode == 1) *(f32x4*)mp = v;
                            else { u32x2 w; w.x = cvt_pk_bf16(v[0], v[1]); w.y = cvt_pk_bf16(v[2], v[3]); *(u32x2*)(mb + (size_t)r * 2048 + c) = w; } } }
                asm volatile("" ::: "memory"); }
    }
};
struct EpiNull { static constexpr bool PERM = true, AFTER_DRAIN = false, MULTISEG = false, AROWPERM = false;
    float* sink; __device__ __forceinline__ void operator()(const f32x4 (&acc)[2][2][4][2], const Unit& u, int wr, int wc, int fr, int fq) const { f32x4 t = {0.f, 0.f, 0.f, 0.f};
#pragma unroll
        for (int a = 0; a < 2; ++a)
#pragma unroll
            for (int b = 0; b < 2; ++b)
#pragma unroll
                for (int m = 0; m < 4; ++m)
#pragma unroll
                    for (int n = 0; n < 2; ++n) t += acc[a][b][m][n];
        if (t[0] + t[1] + t[2] + t[3] == 1.2345e30f) sink[0] = 1.f;
#if REPMASK & 0x20000
        { bf16_t* O = (bf16_t*)sink; const int row0 = u.pm * BM + wr * 64 + fr, col0 = u.pn * BM + wc * 32 + 8 * fq;
#pragma unroll
          for (int ai = 0; ai < 2; ++ai)
#pragma unroll
            for (int m = 0; m < 4; ++m) { const f32x4 v0 = acc[ai][0][m][0], v1 = acc[ai][0][m][1];
                u32x4 w; w.x = cvt_pk_bf16(v0[0], v0[1]); w.y = cvt_pk_bf16(v0[2], v0[3]); w.z = cvt_pk_bf16(v1[0], v1[1]); w.w = cvt_pk_bf16(v1[2], v1[3]);
                __builtin_nontemporal_store(w, (u32x4*)(O + (size_t)(row0 + ai * HALF + m * 16) * 15360 + col0)); } }
#endif
    } };
struct EpiProj {
    static constexpr bool PERM = true, AFTER_DRAIN = false, MULTISEG = false, AROWPERM = false;
    bf16_t* O; int ldc; const float* rope; const float* lbl; float* logh; int layer; const float* hnorm;
    __device__ __forceinline__ void operator()(const f32x4 (&acc)[2][2][4][2], const Unit& u, int wr, int wc, int fr, int fq) const {
        const int pn = u.pn;
        const bool swish = (pn >= 8 && pn < 12) || (pn >= 20 && pn < 24) || (pn >= 32 && pn < 36) || pn == 24 || pn == 25;
        const int mode = pn < 4 ? 1 : ((pn == 12 || pn == 13) ? 2 : (swish ? 3 : ((pn == 26 || pn == 27) ? 4 : 0)));
        if (mode == 1) run<1, false>(acc, u, wr, wc, fr, fq);
        else if (mode == 2) run<2, false>(acc, u, wr, wc, fr, fq);
        else if (mode == 3) run<3, false>(acc, u, wr, wc, fr, fq);
        else if (mode == 4) run<4, false>(acc, u, wr, wc, fr, fq);
        else if (pn >= 36) run<0, true>(acc, u, wr, wc, fr, fq);
        else run<0, false>(acc, u, wr, wc, fr, fq);
    }
    template <int MODE, bool PLAIN>
    __device__ __forceinline__ void run(const f32x4 (&acc)[2][2][4][2], const Unit& u, int wr, int wc, int fr, int fq) const {
        const int row0 = u.pm * BM + wr * 64 + fr, col0 = u.pn * BM + wc * 32 + 8 * fq; const int pn = u.pn;
        const float ks = (pn == 2 || pn == 3 || MODE == 2) ? 0.08838834764831845f : 1.0f;
        float lb[2][8];
        if (MODE == 3) {
#pragma unroll
            for (int bj = 0; bj < 2; ++bj)
#pragma unroll
                for (int e = 0; e < 8; ++e) lb[bj][e] = 1.0f;
            if (pn != 24 && pn != 25) {
#pragma unroll
                for (int bj = 0; bj < 2; ++bj) { const float* hp = hnorm + ((pn - 8) / 12) * 256 + ((bj * HALF + wc * 32 + 8 * fq) & 255); const f32x4 h0 = *(const f32x4*)hp, h1 = *(const f32x4*)(hp + 4);
                    lb[bj][0] = h0.x; lb[bj][1] = h0.y; lb[bj][2] = h0.z; lb[bj][3] = h0.w; lb[bj][4] = h1.x; lb[bj][5] = h1.y; lb[bj][6] = h1.z; lb[bj][7] = h1.w; } } }
        if (MODE == 4) {
#pragma unroll
            for (int bj = 0; bj < 2; ++bj)
#pragma unroll
                for (int e = 0; e < 8; ++e) lb[bj][e] = 0.f;
            if (layer != 0) { f32x4 la_[4], lb_[4];
#pragma unroll
                for (int bj = 0; bj < 2; ++bj) { const int c = (pn - 26) * 256 + bj * HALF + wc * 32 + 8 * fq;
                    la_[2 * bj] = *(const f32x4*)(lbl + c); la_[2 * bj + 1] = *(const f32x4*)(lbl + c + 4); lb_[2 * bj] = *(const f32x4*)(lbl + 512 + c); lb_[2 * bj + 1] = *(const f32x4*)(lbl + 512 + c + 4); }
                asm volatile("" : "+v"(la_[0]), "+v"(la_[1]), "+v"(la_[2]), "+v"(la_[3]), "+v"(lb_[0]), "+v"(lb_[1]), "+v"(lb_[2]), "+v"(lb_[3]));
#pragma unroll
                for (int bj = 0; bj < 2; ++bj)
#pragma unroll
                    for (int e = 0; e < 8; ++e) lb[bj][e] = fast_sigmoid(lb_[2 * bj + (e >> 2)][e & 3] - la_[2 * bj + (e >> 2)][e & 3]); }
        }
#pragma unroll
        for (int ai = 0; ai < 2; ++ai) {
            f32x4 csA[4], snA[4];
            if (MODE == 1) {
#pragma unroll
                for (int m = 0; m < 4; ++m) { const int r = row0 + ai * HALF + m * 16; const int pidx = r < 8192 ? (r & 2047) : 2048 + ((r - 8192) & 3); const float* rp = rope + (size_t)pidx * 128 + 16 * wc + 4 * fq;
                    csA[m] = *(const f32x4*)rp; snA[m] = *(const f32x4*)(rp + 64); }
                asm volatile("" : "+v"(csA[0]), "+v"(csA[1]), "+v"(csA[2]), "+v"(csA[3]), "+v"(snA[0]), "+v"(snA[1]), "+v"(snA[2]), "+v"(snA[3])); }
#pragma unroll
            for (int m = 0; m < 4; ++m) { const int r = row0 + ai * HALF + m * 16; bf16_t* rowp = O + (size_t)r * ldc + col0;
#pragma unroll
                for (int bj = 0; bj < 2; ++bj) { f32x4 v0 = acc[ai][bj][m][0], v1 = acc[ai][bj][m][1];
                    if (MODE == 1) { const f32x4 cs4 = csA[m], sn4 = snA[m]; const f32x4 y1 = (v0 * cs4 - v1 * sn4) * ks, y2 = (v0 * sn4 + v1 * cs4) * ks; v0 = y1; v1 = y2; }
                    else if (MODE == 2) { v0 = v0 * ks; v1 = v1 * ks; }
                    else if (MODE == 3) {
#pragma unroll
                        for (int e = 0; e < 4; ++e) { v0[e] = v0[e] * fast_sigmoid(v0[e]); v1[e] = v1[e] * fast_sigmoid(v1[e]); }
                        v0 = v0 * (f32x4){lb[bj][0], lb[bj][1], lb[bj][2], lb[bj][3]}; v1 = v1 * (f32x4){lb[bj][4], lb[bj][5], lb[bj][6], lb[bj][7]}; }
                    else if (MODE == 4) { f32x4 g0, g1;
#pragma unroll
                        for (int e = 0; e < 4; ++e) {
                            { const float t = __builtin_amdgcn_exp2f(-1.44269504f * v0[e]), sg = __builtin_amdgcn_rcpf(1.0f + t), l_ = lb[bj][e];
                              g0[e] = __builtin_amdgcn_logf(fmaxf(l_ + (1.0f - l_) * sg, 1e-37f)); v0[e] = (1.0f - l_) * (t < 1e30f ? t * sg : 1.0f); }
                            { const float t = __builtin_amdgcn_exp2f(-1.44269504f * v1[e]), sg = __builtin_amdgcn_rcpf(1.0f + t), l_ = lb[bj][4 + e];
                              g1[e] = __builtin_amdgcn_logf(fmaxf(l_ + (1.0f - l_) * sg, 1e-37f)); v1[e] = (1.0f - l_) * (t < 1e30f ? t * sg : 1.0f); } }
                        float* lp = logh + (size_t)r * 512 + (pn - 26) * 256 + bj * HALF + wc * 32 + 8 * fq; *(f32x4*)lp = g0; *(f32x4*)(lp + 4) = g1; }
                    u32x4 w; w.x = cvt_pk_bf16(v0[0], v0[1]); w.y = cvt_pk_bf16(v0[2], v0[3]); w.z = cvt_pk_bf16(v1[0], v1[1]); w.w = cvt_pk_bf16(v1[2], v1[3]);
                    if (!PLAIN) __builtin_nontemporal_store(w, (u32x4*)(rowp + bj * HALF)); else *(u32x4*)(rowp + bj * HALF) = w; } } }
    }
};
__device__ __forceinline__ float dpp_shr1(float x) { return __builtin_bit_cast(float, __builtin_amdgcn_update_dpp(0, __builtin_bit_cast(int, x), 0x111, 0xf, 0xf, true)); }
struct EpiUpConv {
    static constexpr bool PERM = true, AFTER_DRAIN = false, MULTISEG = false, AROWPERM = true;
    bf16_t* ACT; const float* cw; const float* cb; const float* sconv; float* UH; float* sconv_out;
    __device__ __forceinline__ void operator()(const f32x4 (&acc)[2][2][4][2], const Unit& u, int wr, int wc, int fr, int fq) const {
        const int pn = u.pn, pm = u.pm; const bool prm = pm < 32;
        const int tok0 = 128 * wr + 8 * fr;
        u32x2 y0p[8];
#pragma unroll
        for (int n = 0; n < 2; ++n) {
            const int cl = 128 * pn + 32 * wc + 8 * fq + 4 * n;
            const f32x4 wa0 = *(const f32x4*)(cw + cl), wa1 = *(const f32x4*)(cw + 11264 + cl), wa2 = *(const f32x4*)(cw + 22528 + cl), ba = *(const f32x4*)(cb + cl);
            const f32x4 wb0 = *(const f32x4*)(cw + 5632 + cl), wb1 = *(const f32x4*)(cw + 11264 + 5632 + cl), wb2 = *(const f32x4*)(cw + 22528 + 5632 + cl), bb = *(const f32x4*)(cb + 5632 + cl);
            f32x4 a2, a1, b2, b1;
            f32x4 sc2[4];
#pragma unroll
            for (int i = 0; i < 4; ++i) sc2[i] = (f32x4){0.f, 0.f, 0.f, 0.f};
            if (prm) {
#pragma unroll
                for (int e = 0; e < 4; ++e) { a2[e] = dpp_shr1(acc[1][0][2][n][e]); a1[e] = dpp_shr1(acc[1][0][3][n][e]); b2[e] = dpp_shr1(acc[1][1][2][n][e]); b1[e] = dpp_shr1(acc[1][1][3][n][e]); }
                if (fr == 0 || fr == 15) {
                    float* uh = UH + ((size_t)pm * 8 + 4 * wr + (fr == 15 ? 2 : 0)) * 11264 + cl;
                    const bool hi = fr == 15;
                    *(f32x4*)uh = hi ? acc[1][0][2][n] : acc[0][0][0][n]; *(f32x4*)(uh + 5632) = hi ? acc[1][1][2][n] : acc[0][1][0][n];
                    *(f32x4*)(uh + 11264) = hi ? acc[1][0][3][n] : acc[0][0][1][n]; *(f32x4*)(uh + 11264 + 5632) = hi ? acc[1][1][3][n] : acc[0][1][1][n]; }
            } else {
                const float* sp = sconv + (size_t)((256 * (pm - 32) + tok0) >> 2) * 2 * 11264 + cl;
                a2 = *(const f32x4*)sp; b2 = *(const f32x4*)(sp + 5632); a1 = *(const f32x4*)(sp + 11264); b1 = *(const f32x4*)(sp + 11264 + 5632);
                const float* sq = sp + 2 * 11264;
                sc2[0] = *(const f32x4*)sq; sc2[1] = *(const f32x4*)(sq + 5632); sc2[2] = *(const f32x4*)(sq + 11264); sc2[3] = *(const f32x4*)(sq + 11264 + 5632);
            }
#pragma unroll
            for (int j = 0; j < 8; ++j) {
                const int ai = j >> 2, m = j & 3;
                if (!prm && j == 4) { a2 = sc2[0]; b2 = sc2[1]; a1 = sc2[2]; b1 = sc2[3]; }
                const f32x4 a0 = acc[ai][0][m][n], b0 = acc[ai][1][m][n];
                const f32x4 ca = ba + wa0 * a2 + wa1 * a1 + wa2 * a0, cbv = bb + wb0 * b2 + wb1 * b1 + wb2 * b0;
                f32x4 y;
#pragma unroll
                for (int e = 0; e < 4; ++e) y[e] = ca[e] * fast_sigmoid(ca[e]) * cbv[e];
                if (n == 0) { y0p[j].x = cvt_pk_bf16(y[0], y[1]); y0p[j].y = cvt_pk_bf16(y[2], y[3]); }
                else if (!(prm && fr == 0 && j < 2)) { u32x4 w; w.x = y0p[j].x; w.y = y0p[j].y; w.z = cvt_pk_bf16(y[0], y[1]); w.w = cvt_pk_bf16(y[2], y[3]);
                    *(u32x4*)(ACT + (size_t)(256 * pm + tok0 + j) * 5632 + cl - 4) = w; }
                if (!prm && (j & 3) >= 2) {
                    float* so = sconv_out + ((size_t)(((256 * (pm - 32) + tok0) >> 2) + (j >> 2)) * 2 + ((j & 3) - 2)) * 11264 + cl;
                    *(f32x4*)so = a0; *(f32x4*)(so + 5632) = b0; }
                a2 = a1; a1 = a0; b2 = b1; b1 = b0;
                asm volatile("" ::: "memory");
            }
            asm volatile("" ::: "memory");
        }
    }
};
struct EpiBranch3 {
    static constexpr bool PERM = true, AFTER_DRAIN = false, MULTISEG = true, AROWPERM = false;
    const bf16_t* gate; int ldg; bf16_t* mb;
    __device__ __forceinline__ void operator()(f32x4 (&acc)[2][2][4][2], const Unit& u, int wr, int wc, int fr, int fq) const {
        const int row0 = u.pm * BM + wr * 64 + fr, col0 = u.pn * BM + wc * 32 + 8 * fq;
#pragma unroll
        for (int ai = 0; ai < 2; ++ai) {
            if (u.seg < 2) {
                u32x4 ga[4][2], gb[4][2];
#pragma unroll
                for (int m = 0; m < 4; ++m)
#pragma unroll
                    for (int bj = 0; bj < 2; ++bj) { const bf16_t* gp = gate + (size_t)(row0 + ai * HALF + m * 16) * ldg + u.seg * 2048 + col0 + bj * HALF; ga[m][bj] = *(const u32x4*)gp; gb[m][bj] = *(const u32x4*)(gp + 2048); }
                asm volatile("" : "+v"(ga[0][0]), "+v"(ga[0][1]), "+v"(ga[1][0]), "+v"(ga[1][1]), "+v"(ga[2][0]), "+v"(ga[2][1]), "+v"(ga[3][0]), "+v"(ga[3][1]),
                                  "+v"(gb[0][0]), "+v"(gb[0][1]), "+v"(gb[1][0]), "+v"(gb[1][1]), "+v"(gb[2][0]), "+v"(gb[2][1]), "+v"(gb[3][0]), "+v"(gb[3][1]));
#pragma unroll
                for (int m = 0; m < 4; ++m)
#pragma unroll
                    for (int bj = 0; bj < 2; ++bj) { f32x4 v0 = acc[ai][bj][m][0], v1 = acc[ai][bj][m][1];
#pragma unroll
                        for (int e = 0; e < 4; ++e) { const float a0 = bf_lo(ga[m][bj][e]), a1 = bf_hi(ga[m][bj][e]), b0 = fmaxf(bf_lo(gb[m][bj][e]), -60.f), b1 = fmaxf(bf_hi(gb[m][bj][e]), -60.f);
                            const float r0 = (1.0f + __builtin_amdgcn_exp2f(-1.44269504f * b0)) * __builtin_amdgcn_rcpf(1.0f + __builtin_amdgcn_exp2f(-1.44269504f * a0));
                            const float r1 = (1.0f + __builtin_amdgcn_exp2f(-1.44269504f * b1)) * __builtin_amdgcn_rcpf(1.0f + __builtin_amdgcn_exp2f(-1.44269504f * a1));
                            if (e < 2) { v0[2 * e] *= r0; v0[2 * e + 1] *= r1; } else { v1[2 * (e - 2)] *= r0; v1[2 * (e - 2) + 1] *= r1; } }
                        acc[ai][bj][m][0] = v0; acc[ai][bj][m][1] = v1; }
            } else {
                u32x4 ga[4][2];
#pragma unroll
                for (int m = 0; m < 4; ++m)
#pragma unroll
                    for (int bj = 0; bj < 2; ++bj) ga[m][bj] = *(const u32x4*)(gate + (size_t)(row0 + ai * HALF + m * 16) * ldg + u.seg * 2048 + col0 + bj * HALF);
                asm volatile("" : "+v"(ga[0][0]), "+v"(ga[0][1]), "+v"(ga[1][0]), "+v"(ga[1][1]), "+v"(ga[2][0]), "+v"(ga[2][1]), "+v"(ga[3][0]), "+v"(ga[3][1]));
#pragma unroll
                for (int m = 0; m < 4; ++m)
#pragma unroll
                    for (int bj = 0; bj < 2; ++bj) { f32x4 v0 = acc[ai][bj][m][0], v1 = acc[ai][bj][m][1];
#pragma unroll
                        for (int e = 0; e < 4; ++e) { const float s0 = fast_sigmoid(bf_lo(ga[m][bj][e])), s1 = fast_sigmoid(bf_hi(ga[m][bj][e]));
                            if (e < 2) { v0[2 * e] *= s0; v0[2 * e + 1] *= s1; } else { v1[2 * (e - 2)] *= s0; v1[2 * (e - 2) + 1] *= s1; } }
                        u32x4 w; w.x = cvt_pk_bf16(v0[0], v0[1]); w.y = cvt_pk_bf16(v0[2], v0[3]); w.z = cvt_pk_bf16(v1[0], v1[1]); w.w = cvt_pk_bf16(v1[2], v1[3]);
                        *(u32x4*)(mb + (size_t)(row0 + ai * HALF + m * 16) * 2048 + col0 + bj * HALF) = w; }
            }
            asm volatile("" ::: "memory"); }
    }
};
struct SegOrder : StaticOrder {
    __host__ __device__ __forceinline__ bool next(int i, Unit& u) const { const int it = i / 3; if (!StaticOrder::next(it, u)) return false; u.seg = i - 3 * it; return true; }
};
struct EpiResid {
    static constexpr bool PERM = true, AFTER_DRAIN = false, MULTISEG = false, AROWPERM = false;
    const float* xin_p; const float* xin_s; const bf16_t* xin_b; bf16_t* xout; const float* gvec;
    __device__ __forceinline__ void operator()(const f32x4 (&acc)[2][2][4][2], const Unit& u, int wr, int wc, int fr, int fq) const {
        const int row0 = u.pm * BM + wr * 64 + fr, col0 = u.pn * BM + wc * 32 + 8 * fq;
        f32x4 gq[2][2];
        { const float* gr = gvec + (size_t)(u.pm >> 3) * 12288 + col0;
#pragma unroll
            for (int bj = 0; bj < 2; ++bj) { gq[bj][0] = *(const f32x4*)(gr + bj * HALF); gq[bj][1] = *(const f32x4*)(gr + bj * HALF + 4); } }
#define RESID_OUT(m_, bj_, x0_, x1_) do { const int r = row0 + ai * HALF + (m_) * 16, c = col0 + (bj_) * HALF; \
            const f32x4 g0 = gq[bj_][0], g1 = gq[bj_][1]; \
            const f32x4 o0 = (x0_) + g0 * acc[ai][bj_][m_][0], o1 = (x1_) + g1 * acc[ai][bj_][m_][1]; \
            u32x4 w; w.x = cvt_pk_bf16(o0[0], o0[1]); w.y = cvt_pk_bf16(o0[2], o0[3]); w.z = cvt_pk_bf16(o1[0], o1[1]); w.w = cvt_pk_bf16(o1[2], o1[3]); \
            *(u32x4*)(xout + (size_t)r * 2048 + c) = w; } while (0)
        if (xin_p) {
#pragma unroll
            for (int ai = 0; ai < 2; ++ai)
#pragma unroll
                for (int mp = 0; mp < 2; ++mp) {
                    f32x4 xa[2][2][2];
#pragma unroll
                    for (int mm = 0; mm < 2; ++mm)
#pragma unroll
                        for (int bj = 0; bj < 2; ++bj) { const int r = row0 + ai * HALF + (2 * mp + mm) * 16, c = col0 + bj * HALF;
                            const float* xr = r < 8192 ? xin_p + (size_t)r * 2048 : xin_s + (size_t)(r - 8192) * 2048; xa[mm][bj][0] = *(const f32x4*)(xr + c); xa[mm][bj][1] = *(const f32x4*)(xr + c + 4); }
                    asm volatile("" : "+v"(xa[0][0][0]), "+v"(xa[0][0][1]), "+v"(xa[0][1][0]), "+v"(xa[0][1][1]), "+v"(xa[1][0][0]), "+v"(xa[1][0][1]), "+v"(xa[1][1][0]), "+v"(xa[1][1][1]));
#pragma unroll
                    for (int mm = 0; mm < 2; ++mm) { RESID_OUT(2 * mp + mm, 0, xa[mm][0][0], xa[mm][0][1]); RESID_OUT(2 * mp + mm, 1, xa[mm][1][0], xa[mm][1][1]); }
                    asm volatile("" ::: "memory"); }
        } else {
            u32x4 xb[2][4][2];
#pragma unroll
            for (int ai = 0; ai < 2; ++ai)
#pragma unroll
                for (int m = 0; m < 4; ++m)
#pragma unroll
                    for (int bj = 0; bj < 2; ++bj) xb[ai][m][bj] = *(const u32x4*)(xin_b + (size_t)(row0 + ai * HALF + m * 16) * 2048 + col0 + bj * HALF);
            asm volatile("" : "+v"(xb[0][0][0]), "+v"(xb[0][0][1]), "+v"(xb[0][1][0]), "+v"(xb[0][1][1]), "+v"(xb[0][2][0]), "+v"(xb[0][2][1]), "+v"(xb[0][3][0]), "+v"(xb[0][3][1]),
                              "+v"(xb[1][0][0]), "+v"(xb[1][0][1]), "+v"(xb[1][1][0]), "+v"(xb[1][1][1]), "+v"(xb[1][2][0]), "+v"(xb[1][2][1]), "+v"(xb[1][3][0]), "+v"(xb[1][3][1]));
#pragma unroll
            for (int ai = 0; ai < 2; ++ai) {
#pragma unroll
                for (int m = 0; m < 4; ++m) {
                    { const u32x4 t = xb[ai][m][0]; const f32x4 x0 = {bf_lo(t.x), bf_hi(t.x), bf_lo(t.y), bf_hi(t.y)}, x1 = {bf_lo(t.z), bf_hi(t.z), bf_lo(t.w), bf_hi(t.w)}; RESID_OUT(m, 0, x0, x1); }
                    { const u32x4 t = xb[ai][m][1]; const f32x4 x0 = {bf_lo(t.x), bf_hi(t.x), bf_lo(t.y), bf_hi(t.y)}, x1 = {bf_lo(t.z), bf_hi(t.z), bf_lo(t.w), bf_hi(t.w)}; RESID_OUT(m, 1, x0, x1); } }
                asm volatile("" ::: "memory"); }
        }
#undef RESID_OUT
    }
};

template <class Epi, class Sched, bool ALIGN_EPI = false, bool SP2 = false>
__device__ __forceinline__ void gemm_phase(PG8_LAS unsigned char* lds, const Gemm g, const Sched& S, const Epi& E, const int wave_in) {
    unsigned ones_ = ~0u; asm volatile("" : "+s"(ones_)); int tid_ = wave_in * 64 + (int)__builtin_amdgcn_mbcnt_hi(ones_, __builtin_amdgcn_mbcnt_lo(ones_, 0u)); asm volatile("" : "+v"(tid_));
    const int tid = tid_, wid = wave_in, lane = tid & 63, wr = wid >> 2, wc = wid & 3, fr = lane & 15, fq = lane >> 4;
    const int K = g.K, nt = K / BK;
    unsigned voffA[2], voffB[2];
#pragma unroll
    for (int i = 0; i < 2; ++i) { int R, C; stage_rc(tid * 16 + i * 8192, R, C); const int Rb = Epi::PERM ? ((R & ~31) + perm32(R & 31)) : R;
        const int Ra = Epi::AROWPERM ? 128 * ((R >> 6) & 1) + 8 * (R & 15) + ((R >> 4) & 3) : R;
        voffA[i] = (unsigned)(Ra * K + C) * 2u; voffB[i] = (unsigned)(Rb * K + C) * 2u; }
    const size_t kstep = (size_t)(BK * 2);
    const size_t hstep = (size_t)HALF * K * 2;
    const size_t hstepB = hstep, hstepA = Epi::AROWPERM ? (size_t)4 * K * 2 : hstep;
    const size_t tstep = 2 * hstep;
    const unsigned ldsw = (unsigned)wid * 1024u;
    const int aoff = lds_byte(wr * 64 + fr, fq * 8), boff = lds_byte(wc * 32 + fr, fq * 8);
#define PG8_SA(b, h) (((b) * 2 + (h)) * HTB)
#define PG8_SB(b, h) ((4 + (b) * 2 + (h)) * HTB)
#define PG8_STAGE(bufoff, gbase, voff) do { _Pragma("unroll") for (int _i = 0; _i < 2; ++_i) \
        __builtin_amdgcn_global_load_lds((const unsigned*)((const char*)(gbase) + (voff)[_i]), (PG8_LAS unsigned*)(lds + (bufoff) + ldsw + _i * 8192), 16, 0, 0); } while (0)
#define PG8_LDA(dst, b, h) do { _Pragma("unroll") for (int m = 0; m < 4; ++m) _Pragma("unroll") for (int k = 0; k < 2; ++k) dst[m][k] = *(const PG8_LAS bf16x8*)(lds + PG8_SA(b, h) + aoff + m * 2048 + k * 1024); } while (0)
#define PG8_LDB(dst, b, h) do { _Pragma("unroll") for (int n = 0; n < 2; ++n) _Pragma("unroll") for (int k = 0; k < 2; ++k) dst[n][k] = *(const PG8_LAS bf16x8*)(lds + PG8_SB(b, h) + boff + n * 2048 + k * 1024); } while (0)
#define PG8_MMA(ai, bj, At, Bt) do { __builtin_amdgcn_s_setprio(1); _Pragma("unroll") for (int m = 0; m < 4; ++m) _Pragma("unroll") for (int n = 0; n < 2; ++n) _Pragma("unroll") for (int k = 0; k < 2; ++k) \
        acc[ai][bj][m][n] = __builtin_amdgcn_mfma_f32_16x16x32_bf16(Bt[n][k], At[m][k], acc[ai][bj][m][n], 0, 0, 0); __builtin_amdgcn_s_setprio(0); } while (0)
#define PG8_WAIT_V(n) asm volatile("s_waitcnt vmcnt(" #n ")" ::: "memory")
#define PG8_WAIT_L(n) asm volatile("s_waitcnt lgkmcnt(" #n ")" ::: "memory")
#define PG8_BAR __builtin_amdgcn_s_barrier()
#define PG8_SCHED __builtin_amdgcn_sched_barrier(0)
    Unit cur, nxt; int ui = 0;
    if (!S.next(0, cur)) return;
    f32x4 acc[2][2][4][2];
#pragma unroll
    for (int a = 0; a < 2; ++a)
#pragma unroll
        for (int b = 0; b < 2; ++b)
#pragma unroll
            for (int m = 0; m < 4; ++m)
#pragma unroll
                for (int n = 0; n < 2; ++n) acc[a][b][m][n] = (f32x4){0.f, 0.f, 0.f, 0.f};
    bf16x8 At[4][2], B0[2][2], B1[2][2];
    const char* cA = (const char*)(g.A + cur.seg * g.a_seg) + (size_t)cur.pm * tstep; const char* cB = (const char*)(g.Bt + cur.seg * g.b_seg) + (size_t)cur.pn * tstep;
    S.a_ready(cur);
    if constexpr (SP2) {
        PG8_STAGE(PG8_SB(0, 0), cB, voffB); PG8_STAGE(PG8_SB(0, 1), cB + hstepB, voffB); PG8_STAGE(PG8_SA(0, 0), cA, voffA); PG8_STAGE(PG8_SA(0, 1), cA + hstepA, voffA);
        if (wr == 1) PG8_BAR;
        PG8_WAIT_V(2); PG8_BAR;
        PG8_STAGE(PG8_SB(1, 0), cB + kstep, voffB); PG8_STAGE(PG8_SA(1, 0), cA + kstep, voffA); PG8_STAGE(PG8_SB(1, 1), cB + hstepB + kstep, voffB);
        PG8_WAIT_V(6); PG8_BAR;
    } else {
        PG8_STAGE(PG8_SB(0, 0), cB, voffB); PG8_STAGE(PG8_SA(0, 0), cA, voffA); PG8_STAGE(PG8_SB(0, 1), cB + hstepB, voffB); PG8_STAGE(PG8_SA(0, 1), cA + hstepA, voffA);
        if (wr == 1) PG8_BAR;
        PG8_WAIT_V(4); PG8_BAR;
        PG8_STAGE(PG8_SB(1, 0), cB + kstep, voffB); PG8_STAGE(PG8_SA(1, 0), cA + kstep, voffA); PG8_STAGE(PG8_SB(1, 1), cB + hstepB + kstep, voffB);
        PG8_WAIT_V(6); PG8_BAR;
    }
    for (;;) {
        const bool has_next = S.next(ui + 1, nxt);
        const char* nA = has_next ? (const char*)(g.A + nxt.seg * g.a_seg) + (size_t)nxt.pm * tstep : cA; const char* nB = has_next ? (const char*)(g.Bt + nxt.seg * g.b_seg) + (size_t)nxt.pn * tstep : cB;
        for (int t = 0; t < nt; t += 2) {
            const bool last = (t == nt - 2);
            const char* a1 = cA + (size_t)(t + 1) * kstep;
            const char* a2 = last ? nA : cA + (size_t)(t + 2) * kstep; const char* b2 = last ? nB : cB + (size_t)(t + 2) * kstep;
            const char* a3 = a2 + kstep; const char* b3 = b2 + kstep;
            if (last && has_next) S.a_ready(nxt);
            if constexpr (SP2) {
            PG8_LDB(B0, 0, 0); PG8_LDB(B1, 0, 1); PG8_SCHED; PG8_LDA(At, 0, 0); PG8_STAGE(PG8_SA(1, 1), a1 + hstepA, voffA);
            PG8_WAIT_V(8); PG8_WAIT_L(0); PG8_BAR; PG8_MMA(0, 0, At, B0); PG8_MMA(0, 1, At, B1); PG8_BAR; PG8_SCHED;
            PG8_LDA(At, 0, 1); PG8_STAGE(PG8_SB(0, 0), b2, voffB); PG8_STAGE(PG8_SB(0, 1), b2 + hstepB, voffB); PG8_STAGE(PG8_SA(0, 0), a2, voffA);
            PG8_WAIT_V(8); PG8_WAIT_L(0); PG8_BAR; PG8_MMA(1, 0, At, B0); PG8_MMA(1, 1, At, B1); PG8_BAR; PG8_SCHED;
            PG8_LDB(B0, 1, 0); PG8_LDB(B1, 1, 1); PG8_SCHED; PG8_LDA(At, 1, 0); PG8_STAGE(PG8_SA(0, 1), a2 + hstepA, voffA);
            PG8_WAIT_V(8); PG8_WAIT_L(0); PG8_BAR; PG8_MMA(0, 0, At, B0); PG8_MMA(0, 1, At, B1); PG8_BAR; PG8_SCHED;
            PG8_LDA(At, 1, 1); PG8_STAGE(PG8_SB(1, 0), b3, voffB); PG8_STAGE(PG8_SB(1, 1), b3 + hstepB, voffB); PG8_STAGE(PG8_SA(1, 0), a3, voffA);
            PG8_WAIT_V(8); PG8_WAIT_L(0); PG8_BAR; PG8_MMA(1, 0, At, B0); PG8_MMA(1, 1, At, B1); PG8_BAR; PG8_SCHED;
            } else {
            PG8_LDB(B0, 0, 0); PG8_SCHED; PG8_LDA(At, 0, 0); PG8_STAGE(PG8_SA(1, 1), a1 + hstepA, voffA);
            PG8_WAIT_L(8); PG8_BAR; PG8_WAIT_L(0); PG8_MMA(0, 0, At, B0); PG8_BAR; PG8_SCHED;
            PG8_LDB(B1, 0, 1); PG8_STAGE(PG8_SB(0, 0), b2, voffB);
            PG8_BAR; PG8_WAIT_L(0); PG8_MMA(0, 1, At, B1); PG8_BAR;
            PG8_LDA(At, 0, 1); PG8_STAGE(PG8_SA(0, 0), a2, voffA);
            PG8_BAR; PG8_WAIT_L(0); PG8_MMA(1, 0, At, B0); PG8_BAR; PG8_SCHED;
            PG8_STAGE(PG8_SB(0, 1), b2 + hstepB, voffB);
            PG8_WAIT_V(6); PG8_BAR; PG8_MMA(1, 1, At, B1); PG8_BAR;
            PG8_LDB(B0, 1, 0); PG8_SCHED; PG8_LDA(At, 1, 0); PG8_STAGE(PG8_SA(0, 1), a2 + hstepA, voffA);
            PG8_WAIT_L(8); PG8_BAR; PG8_WAIT_L(0); PG8_MMA(0, 0, At, B0); PG8_BAR; PG8_SCHED;
            PG8_LDB(B1, 1, 1); PG8_STAGE(PG8_SB(1, 0), b3, voffB);
            PG8_BAR; PG8_WAIT_L(0); PG8_MMA(0, 1, At, B1); PG8_BAR;
            PG8_LDA(At, 1, 1); PG8_STAGE(PG8_SA(1, 0), a3, voffA);
            PG8_BAR; PG8_WAIT_L(0); PG8_MMA(1, 0, At, B0); PG8_BAR; PG8_SCHED;
            PG8_STAGE(PG8_SB(1, 1), b3 + hstepB, voffB);
            PG8_WAIT_V(6); PG8_BAR; PG8_MMA(1, 1, At, B1); PG8_BAR;
            }
        }
        if constexpr (ALIGN_EPI) { if (wr == 0) PG8_BAR; }
        if constexpr (!Epi::AFTER_DRAIN) { E(acc, cur, wr, wc, fr, fq); S.done(cur); }
        if (!has_next) break;
        if (!Epi::MULTISEG || nxt.seg == 0)
#pragma unroll
        for (int a = 0; a < 2; ++a)
#pragma unroll
            for (int b = 0; b < 2; ++b)
#pragma unroll
                for (int m = 0; m < 4; ++m)
#pragma unroll
                    for (int n = 0; n < 2; ++n) acc[a][b][m][n] = (f32x4){0.f, 0.f, 0.f, 0.f};
        cur = nxt; cA = nA; cB = nB; ++ui;
        if constexpr (ALIGN_EPI) { if (wr == 1) PG8_BAR; }
    }
    PG8_WAIT_V(0);
    if constexpr (!ALIGN_EPI) { if (wr == 0) PG8_BAR; }
    PG8_BAR;
    if constexpr (Epi::AFTER_DRAIN) { E.fused(acc, cur, wr, wc, fr, fq, lds, wid, lane); S.done(cur); }
#undef PG8_SA
#undef PG8_SB
#undef PG8_STAGE
#undef PG8_LDA
#undef PG8_LDB
#undef PG8_MMA
#undef PG8_WAIT_V
#undef PG8_WAIT_L
#undef PG8_BAR
#undef PG8_SCHED
}
}

#define GAS __attribute__((address_space(1)))
#define LAS __attribute__((address_space(3)))
#define DI __device__ __forceinline__
typedef unsigned short bf16;
typedef unsigned v2u __attribute__((ext_vector_type(2)));
typedef unsigned v4u __attribute__((ext_vector_type(4)));
typedef float f32x2 __attribute__((ext_vector_type(2)));
typedef float f32x4 __attribute__((ext_vector_type(4)));
typedef float f32x16 __attribute__((ext_vector_type(16)));
typedef short bf16x8 __attribute__((ext_vector_type(8)));
typedef short s16x4 __attribute__((ext_vector_type(4)));
typedef __bf16 hbf2 __attribute__((ext_vector_type(2)));

constexpr int NWAVES = 8;
#ifndef GALIGN
#define GALIGN true
#endif
#ifndef GSP2
#define GSP2 true
#endif
#ifndef MK_ONE_LAUNCH
#define MK_ONE_LAUNCH 1
#endif

constexpr int D = 2048, TP = 8192, TS = 512, MROWS = TP + TS, NPROJ = 15360, NIN = 15376, DFF = 5632, NUP = 11264, NBATCH = 132, NMOD = 12288;
constexpr int SEQ = 2048, PAST = 16384;
constexpr int MG_COL = 9216;
constexpr float EPS = 1e-6f, LOG2E = 1.4426950408889634f, KSCALE = 0.08838834764831845f;
constexpr size_t O_YP = 0, O_YS = 16777216, O_PST = 17825792  , O_PCONV = 20971520, O_SST = 21151744  , O_SCONV = 121815040;
constexpr size_t MiB = 1u << 20;
constexpr size_t WS_CTL = 0, CTL_BYTES = 64 * 1024;
constexpr size_t WS_WIN = 1 * MiB, WS_WBR = 121 * MiB, WS_WOUT = 145 * MiB, WS_WUP = 161 * MiB, WS_WDN = 249 * MiB, WS_MOD = 293 * MiB, WS_AC = 306 * MiB, WS_ROPE = 307 * MiB;
constexpr size_t WS_WG = 128 * 1024;
constexpr size_t WS_XA = 309 * MiB, WS_H = 377 * MiB, WS_PROJ = 411 * MiB, WS_U = WS_PROJ, WS_LOGA = 666 * MiB, WS_ON = 683 * MiB, WS_MF = 734 * MiB, WS_MB = 802 * MiB, WS_ACT = 836 * MiB, WS_DS = 930 * MiB, WS_DT = 949 * MiB, WS_LOGH = 950 * MiB, WS_UH = 967 * MiB, WS_END = 979 * MiB;
constexpr size_t MOD_BYTES = (size_t)2 * NBATCH * NMOD * 4;
constexpr int CW_TMO = 0, CW_QUEUE = 64  , CW_BAR = 4096;
constexpr int LDS_BYTES = 155648;
constexpr int LDS_MISC = 155648 - 256;

DI unsigned pk2(float lo, float hi) { f32x2 v = {lo, hi}; hbf2 r = __builtin_convertvector(v, hbf2); return __builtin_bit_cast(unsigned, r); }
DI float bflo(unsigned u) { return __uint_as_float(u << 16); }
DI float bfhi(unsigned u) { return __uint_as_float(u & 0xffff0000u); }
DI float ex2(float x) { return __builtin_amdgcn_exp2f(x); }
DI float rcp(float x) { return __builtin_amdgcn_rcpf(x); }
DI float sigm(float x) { return rcp(1.0f + ex2(-LOG2E * x)); }
DI float silu(float x) { return x * sigm(x); }
DI float wave_sum(float v) {
#pragma unroll
    for (int o = 1; o < 64; o <<= 1) v += __shfl_xor(v, o);
    return v;
}
typedef const GAS char* gcp_t;
DI gcp_t uni(const void* p) { const unsigned long long v = (unsigned long long)p; const unsigned lo = __builtin_amdgcn_readfirstlane((unsigned)v), hi = __builtin_amdgcn_readfirstlane((unsigned)(v >> 32));
    return (gcp_t)(((unsigned long long)hi << 32) | lo); }
#define LDS_WAIT() asm volatile("s_waitcnt lgkmcnt(0)" ::: "memory")
#define VM_WAIT() asm volatile("s_waitcnt vmcnt(0)" ::: "memory")

#define XB_TMO      128
#define XB_XCNT(j)  (256  + 64 * (j))
#define XB_XSUB(j)  (1280 + 64 * (j))
#define XB_XGEN(j)  (2304 + 64 * (j))
#define XB_TOP      3328
#define XB_TOPGEN   3392
#define XCD_BAR_WORDS 3456
#define XB_SPIN_CAP (1u << 18)

__device__ __forceinline__ unsigned xb_ld(unsigned* p)              { return __hip_atomic_load(p, __ATOMIC_RELAXED, __HIP_MEMORY_SCOPE_AGENT); }
__device__ __forceinline__ unsigned xb_add(unsigned* p, unsigned v) { return __hip_atomic_fetch_add(p, v, __ATOMIC_RELAXED, __HIP_MEMORY_SCOPE_AGENT); }
__device__ __forceinline__ unsigned xb_xcc_id() { return (unsigned)__builtin_amdgcn_s_getreg((3 << 11) | 20) & 0xFu; }
#define XB_SPIN(cond, bar) do { unsigned _sp = 0; while (cond) { __builtin_amdgcn_s_sleep(1); \
    if ((++_sp & 255u) == 0u) { if (xb_ld(&(bar)[XB_TMO])) break; if (_sp > XB_SPIN_CAP) { atomicAdd(&(bar)[XB_TMO], 1u); break; } } } } while (0)

struct XcdBarrier {
    unsigned* bar; unsigned x; int wv;
    volatile LAS unsigned* st;
};

__device__ __forceinline__ XcdBarrier xcd_barrier_post(unsigned* bar, volatile LAS unsigned* st) {
    XcdBarrier b; b.bar = bar; b.x = xb_xcc_id(); b.st = st;
    if (threadIdx.x == 0) (void)xb_add(&bar[XB_XCNT(b.x)], 1u);
    return b;
}
__device__ __forceinline__ void xcd_barrier_complete(unsigned* bar, unsigned x, unsigned& nloc, unsigned& nx) {
    const unsigned G = gridDim.x * gridDim.y * gridDim.z;
    unsigned sum, cnt, mine, sp = 0u;
    for (;;) {
        sum = 0u; cnt = 0u; mine = 0u;
#pragma unroll
        for (unsigned j = 0; j < 16; ++j) { const unsigned c = xb_ld(&bar[XB_XCNT(j)]); sum += c; cnt += (c > 0u) ? 1u : 0u; mine = (j == x) ? c : mine; }
        if (sum == G) break;
        __builtin_amdgcn_s_sleep(1);
        if ((++sp & 255u) == 0u) { if (xb_ld(&bar[XB_TMO])) break; if (sp > XB_SPIN_CAP) { atomicAdd(&bar[XB_TMO], 1u); break; } }
    }
    nloc = mine > 0u ? mine : 1u; nx = cnt > 0u ? cnt : 1u;
}

__device__ __forceinline__ void xcd_barrier(const XcdBarrier& b_in) {
    XcdBarrier b = b_in; asm volatile("" : "+s"(b.bar)); b.bar = (unsigned*)(__attribute__((address_space(1))) unsigned*)b.bar;
    asm volatile("s_waitcnt vmcnt(0)" ::: "memory");
    __syncthreads();
    unsigned ones_ = ~0u; asm volatile("" : "+s"(ones_));
    if (b.wv == 0 && __builtin_amdgcn_mbcnt_hi(ones_, __builtin_amdgcn_mbcnt_lo(ones_, 0u)) == 0u) {
        unsigned* bar = b.bar;
        __builtin_amdgcn_s_waitcnt(0);
        unsigned nloc = b.st[0], nx = b.st[1];
        if (nloc == 0u) { xcd_barrier_complete(bar, b.x, nloc, nx); b.st[0] = nloc; b.st[1] = nx; }
        const unsigned old = xb_add(&bar[XB_XSUB(b.x)], 1u);
        const unsigned gen = old / nloc;
        if (old + 1u == (gen + 1u) * nloc) {
            __builtin_amdgcn_fence(__ATOMIC_RELEASE, "agent");
            asm volatile("s_waitcnt vmcnt(0)" ::: "memory");
            const unsigned og = xb_add(&bar[XB_TOP], 1u);
            const unsigned tg = og / nx;
            if (og + 1u == (tg + 1u) * nx) xb_add(&bar[XB_TOPGEN], 1u);
            else XB_SPIN(xb_ld(&bar[XB_TOPGEN]) == tg, bar);
            __builtin_amdgcn_fence(__ATOMIC_ACQUIRE, "agent");
            xb_add(&bar[XB_XGEN(b.x)], 1u);
            asm volatile("s_waitcnt vmcnt(0)" ::: "memory");
        } else {
            XB_SPIN(xb_ld(&bar[XB_XGEN(b.x)]) == gen, bar);
            __builtin_amdgcn_fence(__ATOMIC_ACQUIRE, "agent");
            asm volatile("s_waitcnt vmcnt(0)" ::: "memory");
        }
    }
    __syncthreads();
}
DI int rope_pos(int c) { return c < 64 ? 8 * (c >> 2) + (c & 3) : 8 * ((c - 64) >> 2) + 4 + ((c - 64) & 3); }
DI int rope_chan(int p) { const int e = p & 7, a = p >> 3; return e < 4 ? 4 * a + e : 64 + 4 * a + (e - 4); }
template <bool ROPEPERM = false, bool UPPERM = false>
DI void transpose_item(const float* W, int ldw, int col0, bf16* WT, int K, int dst_row0, LAS float* scr, int kb, int nb, int lane) {
    const int k0 = 64 * kb, n0 = 32 * nb;
#pragma unroll 8
    for (int i = 0; i < 32; ++i) { const int kk = 2 * i + (lane >> 5); scr[kk * 33 + (lane & 31)] = __builtin_nontemporal_load(W + (size_t)(k0 + kk) * ldw + col0 + n0 + (lane & 31)); }
    LDS_WAIT(); asm volatile("" ::: "memory");
    const int c = lane & 7;
#pragma unroll
    for (int j = 0; j < 4; ++j) { const int n = (lane >> 3) + 8 * j; const LAS float* s = scr + (8 * c) * 33 + n;
        v4u o; o.x = pk2(s[0 * 33], s[1 * 33]); o.y = pk2(s[2 * 33], s[3 * 33]); o.z = pk2(s[4 * 33], s[5 * 33]); o.w = pk2(s[6 * 33], s[7 * 33]);
        int drow = dst_row0 + n0 + n; if (ROPEPERM && (n0 + n) < 1024) drow = dst_row0 + ((n0 + n) & ~127) + rope_pos((n0 + n) & 127);
        if (UPPERM) { const int nn = n0 + n, hb = nn >= DFF ? 1 : 0, x = nn - hb * DFF; drow = dst_row0 + 256 * (x >> 7) + 128 * hb + (x & 127); }
        *(v4u*)(WT + (size_t)drow * K + k0 + 8 * c) = o; }
    LDS_WAIT(); asm volatile("" ::: "memory");
}
DI void p0_prologue(LAS unsigned char* lds, int gw, int NGW, int wave, int lane, const float* w_in, const float* w_br, const float* w_out, const float* w_up, const float* w_dn, const float* cp, const float* cs, unsigned char* ws) {
    LAS float* scr = (LAS float*)(lds + wave * 16384);
    bf16* WIN = (bf16*)(ws + WS_WIN); bf16* WBR = (bf16*)(ws + WS_WBR); bf16* WOUT = (bf16*)(ws + WS_WOUT); bf16* WUP = (bf16*)(ws + WS_WUP); bf16* WDN = (bf16*)(ws + WS_WDN);
    constexpr int I_A = 32 * 192, I_B = 32 * 288, I_C = 3 * 16 * 64, I_D = 32 * 64, I_E = 32 * 352, I_F = 88 * 64, I_L = I_A + I_B + I_C + I_D + I_E + I_F;
    for (int it = gw; it < 2 * I_L; it += NGW) {
        const int l = it / I_L; int r = it % I_L;
        if (r < I_A) { transpose_item<true>(w_in + (size_t)l * D * NIN, NIN, 0, WIN + (size_t)l * NPROJ * D, D, 0, scr, r / 192, r % 192, lane); continue; } r -= I_A;
        if (r < I_B) { transpose_item(w_in + (size_t)l * D * NIN, NIN, 6160, WIN + (size_t)l * NPROJ * D, D, 6144, scr, r / 288, r % 288, lane); continue; } r -= I_B;
        if (r < I_C) { const int br = r / 1024, rr = r % 1024; transpose_item(w_br + (size_t)(l * 3 + br) * 1024 * D, D, 0, WBR + (size_t)(l * 3 + br) * D * 1024, 1024, 0, scr, rr / 64, rr % 64, lane); continue; } r -= I_C;
        if (r < I_D) { transpose_item(w_out + (size_t)l * D * D, D, 0, WOUT + (size_t)l * D * D, D, 0, scr, r / 64, r % 64, lane); continue; } r -= I_D;
        if (r < I_E) { transpose_item<false, true>(w_up + (size_t)l * D * NUP, NUP, 0, WUP + (size_t)l * NUP * D, D, 0, scr, r / 352, r % 352, lane); continue; } r -= I_E;
        transpose_item(w_dn + (size_t)l * DFF * D, D, 0, WDN + (size_t)l * D * DFF, DFF, 0, scr, r / 64, r % 64, lane);
    }
    { v4u* mz = (v4u*)(ws + WS_MOD); for (size_t i = (size_t)gw * 64 + lane; i < MOD_BYTES / 16; i += (size_t)NGW * 64) mz[i] = (v4u){0u, 0u, 0u, 0u}; }
    { bf16* WG = (bf16*)(ws + WS_WG);
      for (int idx = gw * 64 + lane; idx < 2 * 16 * D; idx += NGW * 64) { const int l = idx >> 15, j = (idx >> 11) & 15, k = idx & 2047;
          const float v = w_in[(size_t)l * D * NIN + (size_t)k * NIN + 6144 + j]; const unsigned hi = pk2(v, 0.f) & 0xffffu; const float vh = bflo(hi);
          WG[(size_t)(l * 2 + 0) * 16 * D + j * D + k] = (bf16)hi; WG[(size_t)(l * 2 + 1) * 16 * D + j * D + k] = (bf16)(pk2(v - vh, 0.f) & 0xffffu); } }
    unsigned* AC = (unsigned*)(ws + WS_AC);
    for (int idx = gw * 64 + lane; idx < 160 * 1024; idx += NGW * 64) { const int row = idx >> 10, c2 = (idx & 1023) * 2;
        float a = 0.f, b = 0.f;
        if (row < 4) { a = cp[row * D + c2]; b = cp[row * D + c2 + 1]; } else if (row < NBATCH) { a = cs[(row - 4) * D + c2]; b = cs[(row - 4) * D + c2 + 1]; }
        AC[idx] = pk2(silu(a), silu(b)); }
    float* RT = (float*)(ws + WS_ROPE);
    for (int idx = gw * 64 + lane; idx < 2052 * 64; idx += NGW * 64) { const int p = idx >> 6, j = idx & 63; const int pos = p < SEQ ? p : PAST + (p - SEQ);
        const float inv = (float)exp2(-(double)j * (13.287712379549449 / 64.0));
        const float ang = (float)pos * inv;
        double rev = (double)ang * 0.15915494309189535; rev -= rint(rev);
        const float rv = (float)rev;
        RT[p * 128 + j] = __builtin_amdgcn_cosf(rv); RT[p * 128 + 64 + j] = __builtin_amdgcn_sinf(rv); }
}
DI void p1_mod(int gw, int NGW, int lane, const float* w_ada, const float* b_ada, unsigned char* ws, size_t mod_off) {
    const bf16* AC = (const bf16*)(ws + WS_AC); float* MOD = (float*)(ws + mod_off);
    const int r = lane & 31, h = lane >> 5;
    const int wv_ = gw & 7, cu_ = gw >> 3, ncu_ = NGW >> 3;
    if (wv_ >= 6) return;
    for (int task = cu_ * 6 + wv_; task < 1536; task += ncu_ * 6) {
        const int kh = task & 1, ct = (task >> 1) % 384, l = task / 768, n0 = 32 * ct, kbase = 1024 * kh;
        const float* W = w_ada + (size_t)l * D * NMOD + n0 + r;
        f32x16 acc[5];
#pragma unroll
        for (int i = 0; i < 5; ++i)
#pragma unroll
            for (int q = 0; q < 16; ++q) acc[i][q] = 0.f;
#pragma unroll 1
        for (int kg4 = 0; kg4 < 16; ++kg4) {
            f32x4 bw[4][2]; bf16x8 af[4][5];
#pragma unroll
            for (int s4 = 0; s4 < 4; ++s4) { const int k0 = kbase + 16 * (4 * kg4 + s4) + 8 * h;
#pragma unroll
                for (int j = 0; j < 8; ++j) bw[s4][j >> 2][j & 3] = __builtin_nontemporal_load(W + (size_t)(k0 + j) * NMOD);
#pragma unroll
                for (int i = 0; i < 5; ++i) af[s4][i] = *(const bf16x8*)(AC + (size_t)(32 * i + r) * D + k0); }
            asm volatile("" : "+v"(bw[0][0]), "+v"(bw[0][1]), "+v"(bw[1][0]), "+v"(bw[1][1]), "+v"(bw[2][0]), "+v"(bw[2][1]), "+v"(bw[3][0]), "+v"(bw[3][1]),
                              "+v"(af[0][0]), "+v"(af[0][1]), "+v"(af[0][2]), "+v"(af[0][3]), "+v"(af[0][4]), "+v"(af[1][0]), "+v"(af[1][1]), "+v"(af[1][2]), "+v"(af[1][3]), "+v"(af[1][4]),
                              "+v"(af[2][0]), "+v"(af[2][1]), "+v"(af[2][2]), "+v"(af[2][3]), "+v"(af[2][4]), "+v"(af[3][0]), "+v"(af[3][1]), "+v"(af[3][2]), "+v"(af[3][3]), "+v"(af[3][4]));
#pragma unroll
            for (int s4 = 0; s4 < 4; ++s4) {
                v4u bp; bp.x = pk2(bw[s4][0][0], bw[s4][0][1]); bp.y = pk2(bw[s4][0][2], bw[s4][0][3]); bp.z = pk2(bw[s4][1][0], bw[s4][1][1]); bp.w = pk2(bw[s4][1][2], bw[s4][1][3]);
                const bf16x8 bfrag = __builtin_bit_cast(bf16x8, bp);
#pragma unroll
                for (int i = 0; i < 5; ++i) acc[i] = __builtin_amdgcn_mfma_f32_32x32x16_bf16(af[s4][i], bfrag, acc[i], 0, 0, 0); } }
        const float bias = kh == 0 ? b_ada[l * NMOD + n0 + r] : 0.f;
#pragma unroll
        for (int i = 0; i < 5; ++i)
#pragma unroll
            for (int q = 0; q < 16; ++q) { const int bi = 32 * i + (q & 3) + 8 * (q >> 2) + 4 * h;
                if (bi < NBATCH) atomicAdd(MOD + ((size_t)(l * NBATCH + bi)) * NMOD + n0 + r, acc[i][q] + bias); }
    }
}
DI void xrow_load(f32x4 (&d)[8], int use_in, int row, int lane, const float* xp, const float* xs, const bf16* XA) {
    if (use_in) { const float* xr = row < TP ? xp + (size_t)row * D : xs + (size_t)(row - TP) * D;
#pragma unroll
        for (int j = 0; j < 8; ++j) d[j] = *(const f32x4*)(xr + 4 * lane + 256 * j);
    } else { const bf16* xr = XA + (size_t)row * D;
#pragma unroll
        for (int j = 0; j < 8; ++j) { const v2u t = *(const v2u*)(xr + 4 * lane + 256 * j); d[j] = (f32x4){bflo(t.x), bfhi(t.x), bflo(t.y), bfhi(t.y)}; } }
}
DI int bidx_of(int row) { return row < TP ? (row >> 11) : 4 + ((row - TP) >> 2); }
template <bool GLR>
DI void norm_phase(LAS unsigned char* lds, int gw, int NGW, int tid, int lane, int l, int use_in  , const float* xp, const float* xs, const bf16* XA,
                   const float* nw  , const float* mod  , int sh_idx, int sc_idx, bf16* H,
                   const float* w_in_l  , const float* wlr  , const float* blr  , float* LOGA) {
    LAS float* wT = (LAS float*)lds;
    if (GLR) {
        for (int e = tid; e < 16 * D; e += NWAVES * 64) { const int k = e >> 4, j = e & 15; wT[j * D + k] = w_in_l[(size_t)k * NIN + 6144 + j]; }
        __syncthreads();
    }
    const int npr = 4 * (4 * gw < TP ? (TP - 4 * gw + 4 * NGW - 1) / (4 * NGW) : 0), nsr = gw < TS ? (TS - gw + NGW - 1) / NGW : 0;
#define NORM_ROW(it_) ((it_) < npr ? 4 * gw + ((it_) >> 2) * 4 * NGW + ((it_) & 3) : TP + gw + ((it_) - npr) * NGW)
    f32x4 nx[8];
    if (!GLR && npr + nsr > 0) xrow_load(nx, use_in, NORM_ROW(0), lane, xp, xs, XA);
    int cur_b = -1; f32x4 gsc[8], gsh[8];
    for (int it = 0; it < npr + nsr; ++it) {
        const int row = NORM_ROW(it);
        const int bi = bidx_of(row);
        const float* mr = mod + (size_t)bi * NMOD;
        if (!GLR && bi != cur_b) { cur_b = bi;
            f32x4 tw[8], tsc[8];
#pragma unroll
            for (int j = 0; j < 8; ++j) { const int c = 4 * lane + 256 * j; tw[j] = *(const f32x4*)(nw + c); tsc[j] = *(const f32x4*)(mr + sc_idx * D + c); gsh[j] = *(const f32x4*)(mr + sh_idx * D + c); }
            asm volatile("" : "+v"(tw[0]), "+v"(tw[1]), "+v"(tw[2]), "+v"(tw[3]), "+v"(tw[4]), "+v"(tw[5]), "+v"(tw[6]), "+v"(tw[7]),
                              "+v"(tsc[0]), "+v"(tsc[1]), "+v"(tsc[2]), "+v"(tsc[3]), "+v"(tsc[4]), "+v"(tsc[5]), "+v"(tsc[6]), "+v"(tsc[7]),
                              "+v"(gsh[0]), "+v"(gsh[1]), "+v"(gsh[2]), "+v"(gsh[3]), "+v"(gsh[4]), "+v"(gsh[5]), "+v"(gsh[6]), "+v"(gsh[7]));
#pragma unroll
            for (int j = 0; j < 8; ++j) gsc[j] = tw[j] * (1.0f + tsc[j]); }
        f32x4 v[8]; float ss = 0.f;
#pragma unroll
        for (int j = 0; j < 8; ++j) { if (!GLR) v[j] = nx[j]; }
        if (GLR) xrow_load(v, use_in, row, lane, xp, xs, XA);
#pragma unroll
        for (int j = 0; j < 8; ++j) ss += (v[j].x * v[j].x + v[j].y * v[j].y) + (v[j].z * v[j].z + v[j].w * v[j].w);
        if (!GLR && it + 1 < npr + nsr) xrow_load(nx, use_in, NORM_ROW(it + 1), lane, xp, xs, XA);
        const float rstd = 1.0f / sqrtf(wave_sum(ss) * (1.0f / D) + EPS);
#pragma unroll
        for (int j = 0; j < 8; ++j) { const int c = 4 * lane + 256 * j;
            if (GLR) { const f32x4 w = *(const f32x4*)(nw + c), sc = *(const f32x4*)(mr + sc_idx * D + c), sh = *(const f32x4*)(mr + sh_idx * D + c); v[j] = (v[j] * rstd * w) * (1.0f + sc) + sh; }
            else v[j] = (v[j] * rstd) * gsc[j] + gsh[j];
            v2u o; o.x = pk2(v[j].x, v[j].y); o.y = pk2(v[j].z, v[j].w);
            *(v2u*)(H + (size_t)row * D + c) = o; }
        if (GLR) {
            float la[8];
            { const f32x4 a = *(const f32x4*)(blr + 8 * lane), b = *(const f32x4*)(blr + 8 * lane + 4);
              la[0] = a.x; la[1] = a.y; la[2] = a.z; la[3] = a.w; la[4] = b.x; la[5] = b.y; la[6] = b.z; la[7] = b.w; }
#pragma unroll
            for (int jj = 0; jj < 16; ++jj) { float s = 0.f;
                const f32x4 wa = *(const f32x4*)(wlr + jj * 512 + 8 * lane), wb = *(const f32x4*)(wlr + jj * 512 + 8 * lane + 4);
#pragma unroll
                for (int j = 0; j < 8; ++j) { const f32x4 w = *(const LAS f32x4*)(wT + jj * D + 4 * lane + 256 * j); s += (v[j].x * w.x + v[j].y * w.y) + (v[j].z * w.z + v[j].w * w.w); }
                const float gj = wave_sum(s);
                la[0] += gj * wa.x; la[1] += gj * wa.y; la[2] += gj * wa.z; la[3] += gj * wa.w; la[4] += gj * wb.x; la[5] += gj * wb.y; la[6] += gj * wb.z; la[7] += gj * wb.w;
                asm volatile("" ::: "memory"); }
#pragma unroll
            for (int i = 0; i < 8; ++i) { const float sv = la[i];
                const float t = ex2(-LOG2E * fabsf(sv));
                la[i] = (fminf(sv, 0.f) * LOG2E - __builtin_amdgcn_logf(1.0f + t)) * (1.0f / 16.0f); }
            float* lp = LOGA + (size_t)row * 512 + 8 * lane;
            *(f32x4*)lp = (f32x4){la[0], la[1], la[2], la[3]}; *(f32x4*)(lp + 4) = (f32x4){la[4], la[5], la[6], la[7]};
        }
    }
    if (GLR) __syncthreads();
}
DI void glr_phase(LAS unsigned char* lds, int vcu, int G, int tid, int w, int lane, const bf16* H, const bf16* WG, const float* wlr, const float* blr, float* LOGA) {
    constexpr int L_PG = 0, PGS = 20, PGW = 16 * PGS, L_GF = 8 * PGW * 4;
#define GLR_BAR() do { asm volatile("s_waitcnt lgkmcnt(0)" ::: "memory"); __builtin_amdgcn_s_barrier(); asm volatile("" ::: "memory"); } while (0)
    const int n16 = lane & 15, kg = lane >> 4, cq = lane & 15, rg = lane >> 4, col0 = 64 * w + 4 * cq;
    f32x4 wl[16];
#pragma unroll
    for (int jj = 0; jj < 16; ++jj) wl[jj] = *(const f32x4*)(wlr + jj * 512 + col0);
    const f32x4 bias = *(const f32x4*)(blr + col0);
    bf16x8 a[8], bh[8], bl[8];
#define GLR_LOAD(blk_) do { const bf16* hp_ = H + (size_t)(16 * (blk_) + n16) * D + 256 * w + 8 * kg; const bf16* wp_ = WG + (size_t)n16 * D + 256 * w + 8 * kg; \
        _Pragma("unroll") for (int s_ = 0; s_ < 8; ++s_) { a[s_] = *(const bf16x8*)(hp_ + 32 * s_); bh[s_] = *(const bf16x8*)(wp_ + 32 * s_); bl[s_] = *(const bf16x8*)(wp_ + 16 * D + 32 * s_); } } while (0)
    if (vcu < MROWS / 16) GLR_LOAD(vcu);
    __syncthreads();
    for (int blk = vcu; blk < MROWS / 16; blk += G) {
        const int row0 = 16 * blk;
        f32x4 acc = {0.f, 0.f, 0.f, 0.f};
#pragma unroll
        for (int s_ = 0; s_ < 8; ++s_) { acc = __builtin_amdgcn_mfma_f32_16x16x32_bf16(a[s_], bh[s_], acc, 0, 0, 0); acc = __builtin_amdgcn_mfma_f32_16x16x32_bf16(a[s_], bl[s_], acc, 0, 0, 0); }
#pragma unroll
        for (int i = 0; i < 4; ++i) *(LAS float*)(lds + L_PG + (w * PGW + (4 * kg + i) * PGS + n16) * 4) = acc[i];
        if (blk + G < MROWS / 16) GLR_LOAD(blk + G);
        GLR_BAR();
        if (tid < 256) { const int rr = tid >> 4, nn = tid & 15; float sg = 0.f;
#pragma unroll
            for (int ww = 0; ww < 8; ++ww) sg += *(const LAS float*)(lds + L_PG + (ww * PGW + rr * PGS + nn) * 4);
            *(LAS float*)(lds + L_GF + (rr * PGS + nn) * 4) = sg; }
        GLR_BAR();
#pragma unroll
        for (int i = 0; i < 4; ++i) { const int row = 4 * rg + i;
            const f32x4 ga = *(const LAS f32x4*)(lds + L_GF + (row * PGS) * 4), gb = *(const LAS f32x4*)(lds + L_GF + (row * PGS + 4) * 4),
                        gc = *(const LAS f32x4*)(lds + L_GF + (row * PGS + 8) * 4), gd = *(const LAS f32x4*)(lds + L_GF + (row * PGS + 12) * 4);
            f32x4 o = bias;
            o += ga.x * wl[0] + ga.y * wl[1] + ga.z * wl[2] + ga.w * wl[3];
            o += gb.x * wl[4] + gb.y * wl[5] + gb.z * wl[6] + gb.w * wl[7];
            o += gc.x * wl[8] + gc.y * wl[9] + gc.z * wl[10] + gc.w * wl[11];
            o += gd.x * wl[12] + gd.y * wl[13] + gd.z * wl[14] + gd.w * wl[15];
#pragma unroll
            for (int e = 0; e < 4; ++e) { const float sv = o[e]; const float t = ex2(-LOG2E * fabsf(sv));
                o[e] = (fminf(sv, 0.f) * LOG2E - __builtin_amdgcn_logf(1.0f + t)) * (1.0f / 16.0f); }
            *(f32x4*)(LOGA + (size_t)(row0 + row) * 512 + col0) = o; }
    }
    __syncthreads();
#undef GLR_LOAD
#undef GLR_BAR
}
DI void final_norm_phase(int gw, int NGW, int lane, const bf16* XA, const float* nw, float* out) {
    const int npr = 4 * (4 * gw < TP ? (TP - 4 * gw + 4 * NGW - 1) / (4 * NGW) : 0), nsr = gw < TS ? (TS - gw + NGW - 1) / NGW : 0;
    f32x4 wv[8];
#pragma unroll
    for (int j = 0; j < 8; ++j) wv[j] = *(const f32x4*)(nw + 4 * lane + 256 * j);
    f32x4 nx[8];
    if (npr + nsr > 0) xrow_load(nx, 0, NORM_ROW(0), lane, nullptr, nullptr, XA);
    for (int it = 0; it < npr + nsr; ++it) {
        const int row = NORM_ROW(it);
        float* orow = row < TP ? out + O_YP + (size_t)row * D : out + O_YS + (size_t)(row - TP) * D;
        f32x4 v[8]; float ss = 0.f;
#pragma unroll
        for (int j = 0; j < 8; ++j) { v[j] = nx[j]; ss += (v[j].x * v[j].x + v[j].y * v[j].y) + (v[j].z * v[j].z + v[j].w * v[j].w); }
        if (it + 1 < npr + nsr) xrow_load(nx, 0, NORM_ROW(it + 1), lane, nullptr, nullptr, XA);
        const float rstd = 1.0f / sqrtf(wave_sum(ss) * (1.0f / D) + EPS);
#pragma unroll
        for (int j = 0; j < 8; ++j) { const int c = 4 * lane + 256 * j; __builtin_nontemporal_store(v[j] * rstd * wv[j], (f32x4*)(orow + c)); }
    }
}
#undef NORM_ROW
constexpr int NSEG = 4, CPS = 8, NSA = 256;
constexpr int R_QI = 0, R_QD = 17408, R_KD = 34816, R_KO = 52224, R_KU = 78336, R_V = 96768, R_P = 133632, R_WT = 142848, R_DEC = 146944, R_SS = 147456, R_END = 149504;
static_assert(R_END <= LDS_MISC, "rec LDS map");
#define MFMA32(a, b, c) __builtin_amdgcn_mfma_f32_32x32x16_bf16((a), (b), (c), 0, 0, 0)
#define MFMA16(a, b, c) __builtin_amdgcn_mfma_f32_16x16x32_bf16((a), (b), (c), 0, 0, 0)
#define BAR_LDS() do { asm volatile("s_waitcnt lgkmcnt(0)" ::: "memory"); __builtin_amdgcn_s_barrier(); asm volatile("" ::: "memory"); } while (0)

DI void rec_state(LAS unsigned char* lds, int tid, int w, int lane, int l, int idx, const bf16* proj, const float* loga, const float* logh, float* DS, float* DT) {
    const int seq = idx / (NSEG - 1), seg = idx - seq * (NSEG - 1);
    const int r = seq >> 4, b = (seq >> 2) & 3, hd = seq & 3;
    const int ch0 = 2 * lane, h = lane >> 5, r32 = lane & 31, V0 = 32 * w;
    const int kcol = 3072 * r + hd * 128 + ch0 + 512, vcolbase = 3072 * r + 1024 + hd * 256;
    const float* lg = r == 2 ? logh : loga;
    const float gret = __builtin_amdgcn_logf(1.0f - ex2(-5.0f - (float)hd));
    f32x16 S[4];
#pragma unroll
    for (int i = 0; i < 4; ++i)
#pragma unroll
        for (int q = 0; q < 16; ++q) S[i][q] = 0.f;
    float bt0s = 0.f, bt1s = 0.f;
    unsigned rk[8]; f32x2 rx[8];
    const int vrow = (tid >> 5) & 1, vc8 = (tid & 31) * 8;
    const unsigned koff = (unsigned)kcol * 2u, lgoff = (unsigned)ch0 * 4u, voff = ((unsigned)vrow * NPROJ + (unsigned)vc8) * 2u;
#define RS_LOAD(n_) do { const int ng_ = CPS * seg + (n_); const size_t row0_ = (size_t)b * SEQ + 64 * ng_; \
        _Pragma("unroll") for (int i = 0; i < 8; ++i) { rk[i] = *(const GAS unsigned*)(uni(proj + (row0_ + 8 * w + i) * NPROJ) + koff); \
            if (r != 0) rx[i] = *(const GAS f32x2*)(uni(lg + (row0_ + 8 * w + i) * 512 + hd * 128) + lgoff); } } while (0)
    RS_LOAD(0);
    v4u vr[4];
#define RS_VLOAD(n_) do { const size_t rowv_ = (size_t)b * SEQ + 64 * (CPS * seg + (n_)); \
        _Pragma("unroll") for (int i = 0; i < 4; ++i) vr[i] = *(const GAS v4u*)(uni(proj + (rowv_ + 16 * i + 2 * w) * NPROJ + vcolbase) + voff); } while (0)
    RS_VLOAD(0);
    for (int n = 0; n < CPS; ++n) {
        float c0[8], c1[8], k0[8], k1[8]; float cs0 = 0.f, cs1 = 0.f;
#pragma unroll
        for (int i = 0; i < 8; ++i) { k0[i] = bflo(rk[i]); k1[i] = bfhi(rk[i]);
            const float G0 = r == 0 ? gret : rx[i].x, G1 = r == 0 ? gret : rx[i].y;
            cs0 += G0; cs1 += G1; c0[i] = cs0; c1[i] = cs1; }
        RS_LOAD(n + 1 < CPS ? n + 1 : n);
        *(LAS f32x2*)(lds + R_WT + (w * 128 + ch0) * 4) = (f32x2){cs0, cs1};
        BAR_LDS();
        float st0 = 0.f, st1 = 0.f, T0 = 0.f, T1 = 0.f;
#pragma unroll
        for (int ww = 0; ww < 8; ++ww) { const f32x2 t = *(const LAS f32x2*)(lds + R_WT + (ww * 128 + ch0) * 4); if (ww == w) { st0 = T0; st1 = T1; } T0 += t.x; T1 += t.y; }
        unsigned ku0[4], ku1[4];
#pragma unroll
        for (int i = 0; i < 8; ++i) { const float u0 = k0[i] * ex2(T0 - (st0 + c0[i])), u1 = k1[i] * ex2(T1 - (st1 + c1[i]));
            if (i & 1) { ku0[i >> 1] |= pk2(0.f, u0); ku1[i >> 1] |= pk2(0.f, u1); } else { ku0[i >> 1] = pk2(u0, 0.f); ku1[i >> 1] = pk2(u1, 0.f); } }
        *(LAS v4u*)(lds + R_KU + ch0 * 144 + 16 * w) = (v4u){ku0[0], ku0[1], ku0[2], ku0[3]};
        *(LAS v4u*)(lds + R_KU + (ch0 + 1) * 144 + 16 * w) = (v4u){ku1[0], ku1[1], ku1[2], ku1[3]};
        if (w == 0) *(LAS f32x2*)(lds + R_DEC + ch0 * 4) = (f32x2){ex2(T0), ex2(T1)};
        bt0s += T0; bt1s += T1;
#pragma unroll
        for (int i = 0; i < 4; ++i) *(LAS v4u*)(lds + R_V + (2 * w + vrow + 16 * i) * 576 + vc8 * 2) = vr[i];
        RS_VLOAD(n + 1 < CPS ? n + 1 : n);
        BAR_LDS();
        bf16x8 vf[4];
        { const int g16 = (lane >> 4) & 1, q4 = (lane & 15) >> 2, p4 = lane & 3;
#pragma unroll
          for (int ks = 0; ks < 4; ++ks) { const int off = R_V + (16 * ks + 8 * h + q4) * 576 + (V0 + 16 * g16 + 4 * p4) * 2;
              const s16x4 lo = __builtin_amdgcn_ds_read_tr16_b64_v4i16((LAS s16x4*)(lds + off)), hi = __builtin_amdgcn_ds_read_tr16_b64_v4i16((LAS s16x4*)(lds + off + 4 * 576));
              vf[ks] = __builtin_shufflevector(lo, hi, 0, 1, 2, 3, 4, 5, 6, 7); } }
#pragma unroll
        for (int i = 0; i < 4; ++i) {
#pragma unroll
            for (int g = 0; g < 4; ++g) { const f32x4 dc = *(const LAS f32x4*)(lds + R_DEC + (32 * i + 8 * g + 4 * h) * 4);
                S[i][4 * g] *= dc.x; S[i][4 * g + 1] *= dc.y; S[i][4 * g + 2] *= dc.z; S[i][4 * g + 3] *= dc.w; }
#pragma unroll
            for (int ks = 0; ks < 4; ++ks) { const bf16x8 kf = *(const LAS bf16x8*)(lds + R_KU + (32 * i + r32) * 144 + (16 * ks + 8 * h) * 2);
                S[i] = MFMA32(kf, vf[ks], S[i]); }
            asm volatile("" ::: "memory");
        }
    }
#undef RS_LOAD
    float* so = DS + (size_t)idx * 32768 + V0;
    const unsigned soff = ((unsigned)(4 * h) * 256u + (unsigned)r32) * 4u;
#pragma unroll
    for (int i = 0; i < 4; ++i)
#pragma unroll
        for (int q = 0; q < 16; ++q) *(GAS float*)((GAS char*)uni(so + (size_t)(32 * i + (q & 3) + 8 * (q >> 2)) * 256) + soff) = S[i][q];
    if (w == 0) *(f32x2*)(DT + (size_t)idx * 128 + ch0) = (f32x2){bt0s, bt1s};
    BAR_LDS();
}

DI void rec_prompt(LAS unsigned char* lds, int tid, int w, int lane, int l, int unit, const bf16* proj, const float* loga, const float* logh, const float* head_norm,
                   const float* DS, const float* DT, bf16* ON, float* out) {
    const int seq = unit >> 2, seg = unit & 3;
    const int r = seq >> 4, b = (seq >> 2) & 3, hd = seq & 3;
    const int ch0 = 2 * lane, h = lane >> 5, r32 = lane & 31, V0 = 32 * w;
    const int qcol = 3072 * r + hd * 128 + ch0, kcol = qcol + 512, vcolbase = 3072 * r + 1024 + hd * 256, gcolbase = 3072 * r + 2048 + hd * 256;
    const float* lg = r == 2 ? logh : loga;
    const float gret = __builtin_amdgcn_logf(1.0f - ex2(-5.0f - (float)hd));
    for (int e = tid; e < 9216 / 4; e += NWAVES * 64) ((LAS unsigned*)(lds + R_P))[e] = 0u;
    const unsigned soff = ((unsigned)(4 * h) * 256u + (unsigned)r32) * 4u;
    f32x16 S[4];
#pragma unroll
    for (int i = 0; i < 4; ++i)
#pragma unroll
        for (int q = 0; q < 16; ++q) S[i][q] = 0.f;
    for (int j = 0; j < seg; ++j) { const float* dsj = DS + (size_t)(seq * (NSEG - 1) + j) * 32768 + V0; const float* dtj = DT + (size_t)(seq * (NSEG - 1) + j) * 128;
#pragma unroll
        for (int ih = 0; ih < 2; ++ih) {
            f32x4 dl[2][4], dv[2][4];
#pragma unroll
            for (int ii = 0; ii < 2; ++ii)
#pragma unroll
                for (int g = 0; g < 4; ++g) { const int i = 2 * ih + ii; dl[ii][g] = *(const f32x4*)(dtj + 32 * i + 8 * g + 4 * h);
#pragma unroll
                    for (int e = 0; e < 4; ++e) { const int q = 4 * g + e; dv[ii][g][e] = *(const GAS float*)(uni(dsj + (size_t)(32 * i + (q & 3) + 8 * (q >> 2)) * 256) + soff); } }
            asm volatile("" : "+v"(dl[0][0]), "+v"(dl[0][1]), "+v"(dl[0][2]), "+v"(dl[0][3]), "+v"(dl[1][0]), "+v"(dl[1][1]), "+v"(dl[1][2]), "+v"(dl[1][3]),
                              "+v"(dv[0][0]), "+v"(dv[0][1]), "+v"(dv[0][2]), "+v"(dv[0][3]), "+v"(dv[1][0]), "+v"(dv[1][1]), "+v"(dv[1][2]), "+v"(dv[1][3]));
#pragma unroll
            for (int ii = 0; ii < 2; ++ii)
#pragma unroll
                for (int g = 0; g < 4; ++g)
#pragma unroll
                    for (int e = 0; e < 4; ++e) { const int q = 4 * g + e; S[2 * ih + ii][q] = S[2 * ih + ii][q] * ex2(dl[ii][g][e]) + dv[ii][g][e]; } } }
    bf16* ONr = ON + (size_t)r * MROWS * 1024;
    const int posq = (ch0 & ~12) | ((ch0 & 4) << 1) | ((ch0 & 8) >> 1);
    const int jb = w >> 1;
    unsigned rq[8], rk[8]; f32x2 rx[8];
#pragma unroll
    for (int i = 0; i < 8; ++i) rx[i] = (f32x2){0.f, 0.f};
    const int vrow = (tid >> 5) & 1, vc8 = (tid & 31) * 8;
    const unsigned qoff = (unsigned)qcol * 2u, koff = (unsigned)kcol * 2u, lgoff = (unsigned)ch0 * 4u;
    const unsigned voff = ((unsigned)vrow * NPROJ + (unsigned)vc8) * 2u, goff = ((unsigned)r32 * NPROJ + 4u * (unsigned)h) * 2u, ooff = ((unsigned)r32 * 1024u + 4u * (unsigned)h) * 2u;
#define REC_LOAD(n_) do { const int ng_ = CPS * seg + (n_); const size_t row0_ = (size_t)b * SEQ + 64 * ng_; \
        _Pragma("unroll") for (int i = 0; i < 8; ++i) { gcp_t pb_ = uni(proj + (row0_ + 8 * w + i) * NPROJ); \
            rq[i] = *(const GAS unsigned*)(pb_ + qoff); rk[i] = *(const GAS unsigned*)(pb_ + koff); \
            if (r != 0) rx[i] = *(const GAS f32x2*)(uni(lg + (row0_ + 8 * w + i) * 512 + hd * 128) + lgoff); } } while (0)
    REC_LOAD(0);
    { unsigned zv = 0u; asm volatile("" : "+v"(zv));
#pragma unroll
      for (int i = 0; i < 8; ++i) { rq[i] ^= zv; rk[i] ^= zv; rx[i].x = __uint_as_float(__float_as_uint(rx[i].x) ^ zv); rx[i].y = __uint_as_float(__float_as_uint(rx[i].y) ^ zv); } }
    v4u vr[4];
#define REC_VLOAD(n_) do { const size_t rowv_ = (size_t)b * SEQ + 64 * (CPS * seg + (n_)); \
        _Pragma("unroll") for (int i = 0; i < 4; ++i) vr[i] = *(const GAS v4u*)(uni(proj + (rowv_ + 16 * i + 2 * w) * NPROJ + vcolbase) + voff); } while (0)
    REC_VLOAD(0);
    v2u gt[2][4];
#define REC_GLOAD(n_) do { const size_t rowg_ = (size_t)b * SEQ + 64 * (CPS * seg + (n_)); \
        _Pragma("unroll") for (int tt = 0; tt < 2; ++tt) _Pragma("unroll") for (int g = 0; g < 4; ++g) gt[tt][g] = *(const GAS v2u*)(uni(proj + (rowg_ + 32 * tt) * NPROJ + gcolbase + V0 + 8 * g) + goff); } while (0)
    REC_GLOAD(0);
    for (int n = 0; n < CPS; ++n) {
        const size_t row0 = (size_t)b * SEQ + 64 * (CPS * seg + n);
        float c0[8], c1[8];
        float cs0 = 0.f, cs1 = 0.f;
#pragma unroll
        for (int i = 0; i < 8; ++i) { const float G0 = r == 0 ? gret : rx[i].x, G1 = r == 0 ? gret : rx[i].y; cs0 += G0; cs1 += G1; c0[i] = cs0; c1[i] = cs1; }
        *(LAS f32x2*)(lds + R_WT + (w * 128 + ch0) * 4) = (f32x2){cs0, cs1};
        BAR_LDS();
        float B0[5], B1[5], st0 = 0.f, st1 = 0.f;
        { float p0 = 0.f, p1 = 0.f; B0[0] = 0.f; B1[0] = 0.f;
#pragma unroll
          for (int ww = 0; ww < 8; ++ww) { const f32x2 t = *(const LAS f32x2*)(lds + R_WT + (ww * 128 + ch0) * 4);
              if (ww == w) { st0 = p0; st1 = p1; }
              p0 += t.x; p1 += t.y; if (ww & 1) { B0[(ww + 1) >> 1] = p0; B1[(ww + 1) >> 1] = p1; } } }
        const float Bj0 = jb == 0 ? B0[0] : jb == 1 ? B0[1] : jb == 2 ? B0[2] : B0[3], Bj1 = jb == 0 ? B1[0] : jb == 1 ? B1[1] : jb == 2 ? B1[2] : B1[3];
        const float Bn0 = jb == 0 ? B0[1] : jb == 1 ? B0[2] : jb == 2 ? B0[3] : B0[4], Bn1 = jb == 0 ? B1[1] : jb == 1 ? B1[2] : jb == 2 ? B1[3] : B1[4];
        float fo0[5], fo1[5];
#pragma unroll
        for (int i = 1; i < 5; ++i) { fo0[i] = ex2(fminf(B0[i] - Bn0, 0.f)); fo1[i] = ex2(fminf(B1[i] - Bn1, 0.f)); }
        const float EB0 = ex2(Bj0), EB1 = ex2(Bj1), FB0 = ex2(Bn0 - Bj0), FB1 = ex2(Bn1 - Bj1);
        unsigned ku0[4], ku1[4];
#pragma unroll
        for (int i = 0; i < 8; ++i) {
            const int t = 8 * w + i;
            const float q0i = bflo(rq[i]), q1i = bfhi(rq[i]), k0i = bflo(rk[i]), k1i = bfhi(rk[i]);
            const float bt0 = st0 + c0[i], bt1 = st1 + c1[i];
            const float qd0 = q0i * ex2(bt0 - Bj0), qd1 = q1i * ex2(bt1 - Bj1);
            const float kd0 = k0i * ex2(fminf(Bj0 - bt0, 120.f)), kd1 = k1i * ex2(fminf(Bj1 - bt1, 120.f));
            *(LAS unsigned*)(lds + R_QD + t * 272 + ch0 * 2) = pk2(qd0, qd1);
            *(LAS unsigned*)(lds + R_QI + t * 272 + posq * 2) = pk2(qd0 * EB0, qd1 * EB1);
            *(LAS unsigned*)(lds + R_KD + t * 272 + ch0 * 2) = pk2(kd0, kd1);
            const float kb0 = kd0 * FB0, kb1 = kd1 * FB1;
            if (jb < 1) *(LAS unsigned*)(lds + R_KO + (0 + t) * 272 + ch0 * 2) = pk2(kb0 * fo0[1], kb1 * fo1[1]);
            if (jb < 2) *(LAS unsigned*)(lds + R_KO + (16 + t) * 272 + ch0 * 2) = pk2(kb0 * fo0[2], kb1 * fo1[2]);
            if (jb < 3) *(LAS unsigned*)(lds + R_KO + (48 + t) * 272 + ch0 * 2) = pk2(kb0 * fo0[3], kb1 * fo1[3]);
            const float u0 = kb0 * fo0[4], u1 = kb1 * fo1[4];
            if (i & 1) { ku0[i >> 1] |= pk2(0.f, u0) ; ku1[i >> 1] |= pk2(0.f, u1); } else { ku0[i >> 1] = pk2(u0, 0.f); ku1[i >> 1] = pk2(u1, 0.f); }
            asm volatile("" ::: "memory");
        }
        *(LAS v4u*)(lds + R_KU + ch0 * 144 + 16 * w) = (v4u){ku0[0], ku0[1], ku0[2], ku0[3]};
        *(LAS v4u*)(lds + R_KU + (ch0 + 1) * 144 + 16 * w) = (v4u){ku1[0], ku1[1], ku1[2], ku1[3]};
        if (w == 0) *(LAS f32x2*)(lds + R_DEC + ch0 * 4) = (f32x2){ex2(B0[4]), ex2(B1[4])};
        REC_LOAD(n + 1 < CPS ? n + 1 : n);
        BAR_LDS();
        {
            const int nblk = (w == 4 || w == 5) ? 2 : 1;
            for (int bi = 0; bi < nblk; ++bi) {
                int bI, bJ;
                if (bi == 0) { bI = w < 4 ? w : (w == 4 ? 1 : (w == 7 ? 3 : 2)); bJ = w < 4 ? w : (w == 6 ? 1 : 0); } else { bI = 3; bJ = w == 4 ? 1 : 2; }
                const int kobase = bI == 1 ? 0 : (bI == 2 ? 16 : 48);
                const int kxoff = (bI == bJ) ? R_KD + (16 * bJ) * 272 : R_KO + (kobase + 16 * bJ) * 272;
                f32x4 pa = {0.f, 0.f, 0.f, 0.f};
#pragma unroll
                for (int ks = 0; ks < 4; ++ks) {
                    const bf16x8 af = *(const LAS bf16x8*)(lds + kxoff + (lane & 15) * 272 + (32 * ks + 8 * (lane >> 4)) * 2);
                    const bf16x8 bfr = *(const LAS bf16x8*)(lds + R_QD + (16 * bI + (lane & 15)) * 272 + (32 * ks + 8 * (lane >> 4)) * 2);
                    pa = MFMA16(af, bfr, pa);
                }
                if (bI == bJ) {
#pragma unroll
                    for (int q = 0; q < 4; ++q) if (4 * (lane >> 4) + q > (lane & 15)) pa[q] = 0.f;
                }
                *(LAS v2u*)(lds + R_P + (16 * bI + (lane & 15)) * 144 + (16 * bJ + 4 * (lane >> 4)) * 2) = (v2u){pk2(pa[0], pa[1]), pk2(pa[2], pa[3])};
            }
        }
#pragma unroll
        for (int i = 0; i < 4; ++i) *(LAS v4u*)(lds + R_V + (2 * w + vrow + 16 * i) * 576 + vc8 * 2) = vr[i];
        REC_VLOAD(n + 1 < CPS ? n + 1 : n);
        BAR_LDS();
        bf16x8 vf[4];
        { const int g16 = (lane >> 4) & 1, q4 = (lane & 15) >> 2, p4 = lane & 3;
#pragma unroll
          for (int ks = 0; ks < 4; ++ks) { const int off = R_V + (16 * ks + 8 * h + q4) * 576 + (V0 + 16 * g16 + 4 * p4) * 2;
              const s16x4 lo = __builtin_amdgcn_ds_read_tr16_b64_v4i16((LAS s16x4*)(lds + off)), hi = __builtin_amdgcn_ds_read_tr16_b64_v4i16((LAS s16x4*)(lds + off + 4 * 576));
              vf[ks] = __builtin_shufflevector(lo, hi, 0, 1, 2, 3, 4, 5, 6, 7); } }
        f32x16 OT[2];
#pragma unroll
        for (int tt = 0; tt < 2; ++tt)
#pragma unroll
            for (int q = 0; q < 16; ++q) OT[tt][q] = 0.f;
#pragma unroll
        for (int i = 0; i < 4; ++i)
#pragma unroll
            for (int s = 0; s < 2; ++s) {
                v4u sp; sp.x = pk2(S[i][8 * s], S[i][8 * s + 1]); sp.y = pk2(S[i][8 * s + 2], S[i][8 * s + 3]); sp.z = pk2(S[i][8 * s + 4], S[i][8 * s + 5]); sp.w = pk2(S[i][8 * s + 6], S[i][8 * s + 7]);
                const bf16x8 sa = __builtin_bit_cast(bf16x8, sp);
#pragma unroll
                for (int tt = 0; tt < 2; ++tt) { const bf16x8 qf = *(const LAS bf16x8*)(lds + R_QI + (32 * tt + r32) * 272 + (32 * i + 16 * s + 8 * h) * 2);
                    OT[tt] = MFMA32(sa, qf, OT[tt]); }
                asm volatile("" ::: "memory"); }
#pragma unroll
        for (int tt = 0; tt < 2; ++tt)
#pragma unroll
            for (int ks = 0; ks < 4; ++ks) if (tt == 1 || ks < 2) { const bf16x8 pf = *(const LAS bf16x8*)(lds + R_P + (32 * tt + r32) * 144 + (16 * ks + 8 * h) * 2);
                OT[tt] = MFMA32(vf[ks], pf, OT[tt]); }
#pragma unroll
        for (int i = 0; i < 4; ++i) {
#pragma unroll
            for (int g = 0; g < 4; ++g) { const f32x4 dc = *(const LAS f32x4*)(lds + R_DEC + (32 * i + 8 * g + 4 * h) * 4);
                S[i][4 * g] *= dc.x; S[i][4 * g + 1] *= dc.y; S[i][4 * g + 2] *= dc.z; S[i][4 * g + 3] *= dc.w; }
#pragma unroll
            for (int ks = 0; ks < 4; ++ks) { const bf16x8 kf = *(const LAS bf16x8*)(lds + R_KU + (32 * i + r32) * 144 + (16 * ks + 8 * h) * 2);
                S[i] = MFMA32(kf, vf[ks], S[i]); }
            asm volatile("" ::: "memory");
        }
#pragma unroll
        for (int tt = 0; tt < 2; ++tt) { float ss = 0.f;
#pragma unroll
            for (int q = 0; q < 16; ++q) ss += OT[tt][q] * OT[tt][q];
            ss += __shfl_xor(ss, 32);
            if (lane < 32) *(LAS float*)(lds + R_SS + (w * 64 + 32 * tt + lane) * 4) = ss; }
        BAR_LDS();
        { unsigned zv = 0u; asm volatile("" : "+v"(zv));
#pragma unroll
          for (int i = 0; i < 8; ++i) { rq[i] ^= zv; rk[i] ^= zv; rx[i].x = __uint_as_float(__float_as_uint(rx[i].x) ^ zv); rx[i].y = __uint_as_float(__float_as_uint(rx[i].y) ^ zv); } }
        asm volatile("" : "+v"(rq[0]), "+v"(rq[1]), "+v"(rq[2]), "+v"(rq[3]), "+v"(rq[4]), "+v"(rq[5]), "+v"(rq[6]), "+v"(rq[7]),
                          "+v"(rk[0]), "+v"(rk[1]), "+v"(rk[2]), "+v"(rk[3]), "+v"(rk[4]), "+v"(rk[5]), "+v"(rk[6]), "+v"(rk[7]),
                          "+v"(rx[0]), "+v"(rx[1]), "+v"(rx[2]), "+v"(rx[3]), "+v"(rx[4]), "+v"(rx[5]), "+v"(rx[6]), "+v"(rx[7]) : : "memory");
#pragma unroll
        for (int tt = 0; tt < 2; ++tt) { float tot = 0.f;
#pragma unroll
            for (int ww = 0; ww < 8; ++ww) tot += *(const LAS float*)(lds + R_SS + (ww * 64 + 32 * tt + r32) * 4);
            const float rstd = 1.0f / sqrtf(tot * (1.0f / 256.0f) + EPS);
            GAS char* orow = (GAS char*)uni(ONr + (row0 + 32 * tt) * 1024 + hd * 256 + V0) + ooff;
#pragma unroll
            for (int g = 0; g < 4; ++g) { const v2u gg = gt[tt][g];
                const float y0 = OT[tt][4 * g] * rstd * bflo(gg.x), y1 = OT[tt][4 * g + 1] * rstd * bfhi(gg.x);
                const float y2 = OT[tt][4 * g + 2] * rstd * bflo(gg.y), y3 = OT[tt][4 * g + 3] * rstd * bfhi(gg.y);
                *(GAS v2u*)(orow + 16 * g) = (v2u){pk2(y0, y1), pk2(y2, y3)}; } }
        REC_GLOAD(n + 1 < CPS ? n + 1 : n);
    }
#undef REC_LOAD
    if (seg == NSEG - 1) {
        const unsigned soffF = r == 0 ? ((unsigned)h * 16384u + (unsigned)r32) * 4u : soff;
        float* so = out + O_PST + (size_t)r * 1048576 + ((size_t)(l * 4 + b) * 4 + hd) * 32768 + V0;
#pragma unroll
        for (int i = 0; i < 4; ++i)
#pragma unroll
            for (int q = 0; q < 16; ++q) {
                const int urow = r == 0 ? 16 * i + 4 * (q >> 2) + (q & 3) : 32 * i + (q & 3) + 8 * (q >> 2);
                *(GAS float*)((GAS char*)uni(so + (size_t)urow * 256) + soffF) = S[i][q]; }
    }
    BAR_LDS();
}
struct DecP { unsigned pqa, pka, pv2, pg2; float plg; };
DI void rec_sample_run(LAS unsigned char* lds, int tid, int w, int lane, int l, int idx, int qbase, int su_off, int qend, unsigned* queue, const bf16* proj, const float* loga, const float* logh,
                       const float* head_norm, const float* st0, const float* st1, const float* st2, bf16* ON, float* out) {
    LAS float* PAR = (LAS float*)lds; LAS float* VS = (LAS float*)(lds + 6144); LAS float* PO = (LAS float*)(lds + 10240); LAS float* SS2 = (LAS float*)(lds + 43008);
    volatile LAS int* qslot = (volatile LAS int*)(lds + LDS_MISC + 16);
    const unsigned loff = 16u * (unsigned)lane;
    const int ta = tid >> 7, cha = tid & 127;
    const int tc = w >> 1, cc = 128 * (w & 1) + 2 * lane;
    f32x4 sA[16], sB[16]; DecP pA, pB;
#define S_ISSUE(s_, p_, su_) do { const int r_ = (su_) >> 9, b_ = ((su_) >> 2) & 127, hd_ = (su_) & 3; const size_t row_ = (size_t)TP + 4 * b_ + ta, rowc_ = (size_t)TP + 4 * b_ + tc; \
        const bf16* pr_ = proj + row_ * NPROJ + 3072 * r_ + hd_ * 128 + cha; p_.pqa = pr_[0]; p_.pka = pr_[512]; \
        p_.plg = r_ == 0 ? 0.f : (r_ == 2 ? logh : loga)[row_ * 512 + hd_ * 128 + cha]; \
        p_.pv2 = *(const unsigned*)(proj + row_ * NPROJ + 3072 * r_ + 1024 + hd_ * 256 + 2 * cha); \
        p_.pg2 = *(const unsigned*)(proj + rowc_ * NPROJ + 3072 * r_ + 2048 + hd_ * 256 + cc); \
        const float* S0_ = (r_ == 0 ? st0 : (r_ == 1 ? st1 : st2)) + ((size_t)(l * 128 + b_) * 4 + hd_) * 32768 + (size_t)(16 * w) * 256; \
        _Pragma("unroll") for (int rr = 0; rr < 16; ++rr) s_[rr] = __builtin_nontemporal_load((const GAS f32x4*)(uni(S0_ + rr * 256) + loff)); } while (0)
    constexpr int SSH = (REPMASK >> 13) & 1;
    int su = ((idx - qbase) >> SSH) + su_off;
    S_ISSUE(sA, pA, su);
    if (tid == 0) *qslot = (int)__hip_atomic_fetch_add(queue, 1u, __ATOMIC_RELAXED, __HIP_MEMORY_SCOPE_AGENT);
    BAR_LDS();
    int nidx = __builtin_amdgcn_readfirstlane(*qslot);
    BAR_LDS();
    for (;;) {
#pragma unroll
        for (int ph = 0; ph < 2; ++ph) {
            f32x4 (&s)[16] = ph ? sB : sA; f32x4 (&sn)[16] = ph ? sA : sB; DecP& p = ph ? pB : pA; DecP& pn = ph ? pA : pB;
            const bool has_next = nidx < qend;
            const int nsu = ((nidx - qbase) >> SSH) + su_off;
            int nraw = qend;
            if (tid == 0 && has_next) nraw = (int)__hip_atomic_fetch_add(queue, 1u, __ATOMIC_RELAXED, __HIP_MEMORY_SCOPE_AGENT);
            if (has_next) S_ISSUE(sn, pn, nsu);
            const int r = su >> 9, b = (su >> 2) & 127, hd = su & 3;
            const size_t rowb = (size_t)TP + 4 * b;
            {
                const float f = r == 0 ? 1.0f - ex2(-5.0f - (float)hd) : ex2(p.plg);
                const int chs = r == 0 ? rope_chan(cha) : cha;
                PAR[chs * 12 + ta] = f; PAR[chs * 12 + 4 + ta] = bflo(p.pka); PAR[chs * 12 + 8 + ta] = bflo(p.pqa);
                VS[ta * 256 + 2 * cha] = bflo(p.pv2); VS[ta * 256 + 2 * cha + 1] = bfhi(p.pv2);
            }
            const unsigned cg2 = p.pg2;
            BAR_LDS();
            f32x4 vv[4], oa[4];
#pragma unroll
            for (int t = 0; t < 4; ++t) { vv[t] = *(const LAS f32x4*)(VS + t * 256 + 4 * lane); oa[t] = (f32x4){0.f, 0.f, 0.f, 0.f}; }
            float* So = out + O_SST + (size_t)r * 33554432 + ((size_t)(l * 128 + b) * 4 + hd) * 32768 + (size_t)(16 * w) * 256;
#pragma unroll
            for (int rr = 0; rr < 16; ++rr) { const LAS float* pp = PAR + (16 * w + rr) * 12;
                const f32x4 ff = *(const LAS f32x4*)pp, kk = *(const LAS f32x4*)(pp + 4), qq = *(const LAS f32x4*)(pp + 8);
                f32x4 x = s[rr];
                x = x * ff.x + vv[0] * kk.x; oa[0] += x * qq.x;
                x = x * ff.y + vv[1] * kk.y; oa[1] += x * qq.y;
                x = x * ff.z + vv[2] * kk.z; oa[2] += x * qq.z;
                x = x * ff.w + vv[3] * kk.w; oa[3] += x * qq.w;
                __builtin_nontemporal_store(x, (GAS f32x4*)((GAS char*)uni(So + rr * 256) + loff)); asm volatile("" ::: "memory"); }
#pragma unroll
            for (int t = 0; t < 4; ++t) *(LAS f32x4*)(PO + (w * 4 + t) * 256 + 4 * lane) = oa[t];
            if (tid == 0) *qslot = nraw;
            BAR_LDS();
            const int nidx2 = __builtin_amdgcn_readfirstlane(*qslot);
            {
                float o0 = 0.f, o1 = 0.f;
#pragma unroll
                for (int ww = 0; ww < 8; ++ww) { const f32x2 pq = *(const LAS f32x2*)(PO + (ww * 4 + tc) * 256 + cc); o0 += pq.x; o1 += pq.y; }
                const float ssw = wave_sum(o0 * o0 + o1 * o1);
                if (lane == 0) SS2[w] = ssw;
                BAR_LDS();
                const float rstd = 1.0f / sqrtf((SS2[2 * tc] + SS2[2 * tc + 1]) * (1.0f / 256.0f) + EPS);
                *(unsigned*)(ON + (size_t)r * MROWS * 1024 + (rowb + tc) * 1024 + hd * 256 + cc) = pk2(o0 * rstd * bflo(cg2), o1 * rstd * bfhi(cg2));
            }
            BAR_LDS();
            if (!has_next) goto dec_done;
            su = nsu; nidx = nidx2;
        }
    }
dec_done: ;
#undef S_ISSUE
}
DI void rec_phase(LAS unsigned char* lds, int tid, int w, int lane, int l, unsigned* queue, const XcdBarrier& bar, const bf16* proj, const float* loga, const float* logh, const float* head_norm,
                  const float* st0, const float* st1, const float* st2, float* DS, float* DT, bf16* ON, float* out) {
    volatile LAS int* qslot = (volatile LAS int*)(lds + LDS_MISC + 16);
    constexpr int NP1 = 48 * (NSEG - 1), NP2 = 48 * NSEG, SSH = (REPMASK >> 13) & 1, PSH = (REPMASK >> 12) & 1;
    for (;;) {
        if (tid == 0) *qslot = (int)__hip_atomic_fetch_add(queue, 1u, __ATOMIC_RELAXED, __HIP_MEMORY_SCOPE_AGENT);
        __syncthreads();
        const int idx = __builtin_amdgcn_readfirstlane(*qslot);
        __syncthreads();
        if (idx >= NP1 + (NSA << SSH)) break;
        if (idx < NP1) { for (int rep = 0; rep < NREP(14); ++rep) rec_state(lds, tid, w, lane, l, idx, proj, loga, logh, DS, DT); }
        else { rec_sample_run(lds, tid, w, lane, l, idx, NP1, 0, NP1 + (NSA << SSH), queue, proj, loga, logh, head_norm, st0, st1, st2, ON, out); break; }
    }
    xcd_barrier(bar);
    for (;;) {
        if (tid == 0) *qslot = (int)__hip_atomic_fetch_add(queue + 32, 1u, __ATOMIC_RELAXED, __HIP_MEMORY_SCOPE_AGENT);
        __syncthreads();
        const int idx = __builtin_amdgcn_readfirstlane(*qslot);
        __syncthreads();
        if (idx >= (NP2 << PSH) + ((1536 - NSA) << SSH)) break;
        if (idx < (NP2 << PSH)) rec_prompt(lds, tid, w, lane, l, idx >> PSH, proj, loga, logh, head_norm, DS, DT, ON, out);
        else { rec_sample_run(lds, tid, w, lane, l, idx, (NP2 << PSH), NSA, (NP2 << PSH) + ((1536 - NSA) << SSH), queue + 32, proj, loga, logh, head_norm, st0, st1, st2, ON, out); break; }
    }
}
DI void conv_fix_phase(int gtid, int NT, int l, const float* UH, const float* cw, const float* cb, bf16* ACT, float* out) {
    constexpr int NQ = DFF / 4;
    for (int idx = gtid; idx < 32 * 2 * NQ; idx += NT) {
        const int cq = idx % NQ, g = (idx / NQ) & 1, pm = idx / (2 * NQ), cl = 4 * cq;
        const f32x4 wa0 = *(const f32x4*)(cw + cl), wa1 = *(const f32x4*)(cw + NUP + cl), wa2 = *(const f32x4*)(cw + 2 * NUP + cl), ba = *(const f32x4*)(cb + cl);
        const f32x4 wb0 = *(const f32x4*)(cw + DFF + cl), wb1 = *(const f32x4*)(cw + NUP + DFF + cl), wb2 = *(const f32x4*)(cw + 2 * NUP + DFF + cl), bb = *(const f32x4*)(cb + DFF + cl);
        f32x4 a2 = {0.f, 0.f, 0.f, 0.f}, a1 = a2, b2 = a2, b1 = a2;
        const float* hist = g == 1 ? UH + ((size_t)pm * 8 + 2) * NUP : ((pm & 7) != 0 ? UH + ((size_t)(pm - 1) * 8 + 6) * NUP : nullptr);
        if (hist) { a2 = *(const f32x4*)(hist + cl); b2 = *(const f32x4*)(hist + DFF + cl); a1 = *(const f32x4*)(hist + NUP + cl); b1 = *(const f32x4*)(hist + NUP + DFF + cl); }
        const float* own = UH + ((size_t)pm * 8 + 4 * g) * NUP;
#pragma unroll
        for (int j = 0; j < 2; ++j) {
            const f32x4 a0 = *(const f32x4*)(own + (size_t)j * NUP + cl), b0 = *(const f32x4*)(own + (size_t)j * NUP + DFF + cl);
            const f32x4 ca = ba + wa0 * a2 + wa1 * a1 + wa2 * a0, cbv = bb + wb0 * b2 + wb1 * b1 + wb2 * b0;
            *(v2u*)(ACT + (size_t)(256 * pm + 128 * g + j) * DFF + cl) = (v2u){pk2(silu(ca[0]) * cbv[0], silu(ca[1]) * cbv[1]), pk2(silu(ca[2]) * cbv[2], silu(ca[3]) * cbv[3])};
            a2 = a1; a1 = a0; b2 = b1; b1 = b0; }
        if (g == 1 && (pm & 7) == 7) {
            const float* last = UH + ((size_t)pm * 8 + 6) * NUP; float* so = out + O_PCONV + ((size_t)(l * 4 + (pm >> 3)) * 2) * NUP;
            const f32x4 c0 = *(const f32x4*)(last + cl), c1 = *(const f32x4*)(last + DFF + cl), c2 = *(const f32x4*)(last + NUP + cl), c3 = *(const f32x4*)(last + NUP + DFF + cl);
            *(f32x4*)(so + cl) = c0; *(f32x4*)(so + DFF + cl) = c1; *(f32x4*)(so + NUP + cl) = c2; *(f32x4*)(so + NUP + DFF + cl) = c3;
        }
    }
}
template <int MODE>
DI void sgemm_phase(LAS unsigned char* lds, int blk, int G, int tid, int w, int lane, const bf16* A, size_t a_bstride, const bf16* Bt, size_t b_bstride, int K,
                    bf16* XA, const float* xin_s, const float* gvec, const bf16* gate, bf16* MB) {
    constexpr int ROWB = 528, OPB = 64 * ROWB, SA = 0, SB = 2 * OPB, SRED = 4 * OPB, SGT = SRED, ST = 0, TROW = 272;
    static_assert(SRED + 16384 <= LDS_MISC, "sgemm LDS map");
    const int r32 = lane & 31, h = lane >> 5, quad = w & 3, kh = w >> 2, srow = tid >> 3, skc = (tid & 7) * 8;
    const int nsteps = K / 256;
    for (int tile = blk; tile < 256; tile += G) {
        const int tm = (tile & 31) >> 2, tn = (tile >> 5) * 4 + (tile & 3);
        const int R0 = TP + 64 * tm, C0 = 64 * tn;
        const int erow = R0 + srow, ecol = C0 + skc;
        f32x4 x0 = {0.f, 0.f, 0.f, 0.f}, x1 = x0, g0 = x0, g1 = x0;
        if (MODE == 0) {
            if (xin_s) { const float* xp_ = xin_s + (size_t)(erow - TP) * D + ecol; x0 = *(const f32x4*)xp_; x1 = *(const f32x4*)(xp_ + 4); }
            else { const v4u xr = *(const v4u*)(XA + (size_t)erow * D + ecol); x0[0] = bflo(xr.x); x0[1] = bfhi(xr.x); x0[2] = bflo(xr.y); x0[3] = bfhi(xr.y); x1[0] = bflo(xr.z); x1[1] = bfhi(xr.z); x1[2] = bflo(xr.w); x1[3] = bfhi(xr.w); }
            const float* gp_ = gvec + (size_t)bidx_of(erow) * NMOD + ecol; g0 = *(const f32x4*)gp_; g1 = *(const f32x4*)(gp_ + 4);
        }
        f32x16 tot;
#pragma unroll
        for (int q = 0; q < 16; ++q) tot[q] = 0.f;
        const int nb = MODE == 1 ? 3 : 1;
        for (int br = 0; br < nb; ++br) {
            const bf16* ap = A + br * a_bstride + (size_t)(R0 + srow) * K + skc;
            const bf16* bp = Bt + br * b_bstride + (size_t)(C0 + srow) * K + skc;
            f32x16 acc;
#pragma unroll
            for (int q = 0; q < 16; ++q) acc[q] = 0.f;
            v4u ra[4], rb[4], na[4], nb2[4];
            v4u gt = {0u, 0u, 0u, 0u};
            if (MODE == 1) gt = *(const v4u*)(gate + (size_t)erow * NPROJ + br * D + ecol);
#pragma unroll
            for (int j = 0; j < 4; ++j) { ra[j] = *(const v4u*)(ap + 64 * j); rb[j] = *(const v4u*)(bp + 64 * j); }
            if (MODE == 1) *(LAS v4u*)(lds + SGT + (br & 1) * 8192 + srow * 128 + skc * 2) = gt;
#pragma unroll
            for (int j = 0; j < 4; ++j) { *(LAS v4u*)(lds + SA + srow * ROWB + (skc + 64 * j) * 2) = ra[j]; *(LAS v4u*)(lds + SB + srow * ROWB + (skc + 64 * j) * 2) = rb[j]; }
            if (nsteps > 1) {
#pragma unroll
                for (int j = 0; j < 4; ++j) { ra[j] = *(const v4u*)(ap + 256 + 64 * j); rb[j] = *(const v4u*)(bp + 256 + 64 * j); } }
            __syncthreads();
            for (int st = 0; st < nsteps; ++st) {
                const int cur = st & 1;
                if (st + 2 < nsteps) {
#pragma unroll
                    for (int j = 0; j < 4; ++j) { na[j] = *(const v4u*)(ap + (st + 2) * 256 + 64 * j); nb2[j] = *(const v4u*)(bp + (st + 2) * 256 + 64 * j); } }
#pragma unroll
                for (int j = 0; j < 8; ++j) {
                    const bf16x8 af = *(const LAS bf16x8*)(lds + SA + cur * OPB + (32 * (quad >> 1) + r32) * ROWB + (128 * kh + 16 * j + 8 * h) * 2);
                    const bf16x8 bfr = *(const LAS bf16x8*)(lds + SB + cur * OPB + (32 * (quad & 1) + r32) * ROWB + (128 * kh + 16 * j + 8 * h) * 2);
                    acc = MFMA32(af, bfr, acc); }
                if (st + 1 < nsteps) {
#pragma unroll
                    for (int j = 0; j < 4; ++j) { *(LAS v4u*)(lds + SA + (cur ^ 1) * OPB + srow * ROWB + (skc + 64 * j) * 2) = ra[j]; *(LAS v4u*)(lds + SB + (cur ^ 1) * OPB + srow * ROWB + (skc + 64 * j) * 2) = rb[j]; } }
#pragma unroll
                for (int j = 0; j < 4; ++j) { ra[j] = na[j]; rb[j] = nb2[j]; }
                BAR_LDS();
            }
            if (MODE == 1) {
#pragma unroll
                for (int q = 0; q < 16; ++q) { const int rl = 32 * (quad >> 1) + (q & 3) + 8 * (q >> 2) + 4 * h;
                    const float gv = bflo((unsigned)*(const LAS unsigned short*)(lds + SGT + (br & 1) * 8192 + rl * 128 + (32 * (quad & 1) + r32) * 2));
                    tot[q] += sigm(gv) * acc[q]; }
            } else tot = acc;
        }
        LAS float* red = (LAS float*)(lds + SRED) + (quad * 16) * 64;
        if (MODE == 1) __syncthreads();
        if (kh == 1) {
#pragma unroll
            for (int q = 0; q < 16; ++q) red[q * 64 + lane] = tot[q];
        }
        __syncthreads();
        if (kh == 0) {
#pragma unroll
            for (int q = 0; q < 16; ++q) { const int rl = 32 * (quad >> 1) + (q & 3) + 8 * (q >> 2) + 4 * h, cl = 32 * (quad & 1) + r32;
                *(LAS float*)(lds + ST + rl * TROW + cl * 4) = tot[q] + red[q * 64 + lane]; }
        }
        __syncthreads();
        { const f32x4 t0 = *(const LAS f32x4*)(lds + ST + srow * TROW + skc * 4), t1 = *(const LAS f32x4*)(lds + ST + srow * TROW + skc * 4 + 16);
          v4u o;
          if (MODE == 0) { const f32x4 y0 = x0 + g0 * t0, y1 = x1 + g1 * t1; o.x = pk2(y0[0], y0[1]); o.y = pk2(y0[2], y0[3]); o.z = pk2(y1[0], y1[1]); o.w = pk2(y1[2], y1[3]);
              *(v4u*)((MB ? MB : XA) + (size_t)erow * D + ecol) = o; }
          else { o.x = pk2(t0[0], t0[1]); o.y = pk2(t0[2], t0[3]); o.z = pk2(t1[0], t1[1]); o.w = pk2(t1[2], t1[3]); *(v4u*)(MB + (size_t)erow * D + ecol) = o; } }
        __syncthreads();
    }
}
constexpr int NPH = 21;
struct Args { const float* in[24]; float* out; unsigned char* ws; int ph_lo, ph_hi; };
__global__ void __launch_bounds__(NWAVES * 64, 2) mega(Args args) {
    extern __shared__ __attribute__((aligned(16))) unsigned char lds_raw[];
    LAS unsigned char* lds = (LAS unsigned char*)lds_raw;
    const int tid0 = threadIdx.x, wave0 = __builtin_amdgcn_readfirstlane(tid0 >> 6);
    const int G0 = gridDim.x; const int bx0 = blockIdx.x;
#define PHASE_TID() int wave = wave0, bx = bx0, G = G0; asm volatile("" : "+s"(wave), "+s"(bx), "+s"(G)); \
    const int vcu = (G % 8 == 0) ? (bx % 8) * (G / 8) + bx / 8 : bx; const int gw = vcu * NWAVES + wave, NGW = G * NWAVES; (void)gw; (void)NGW; (void)vcu; \
    unsigned ones_ = ~0u; asm volatile("" : "+s"(ones_)); int tid = wave * 64 + (int)__builtin_amdgcn_mbcnt_hi(ones_, __builtin_amdgcn_mbcnt_lo(ones_, 0u)); asm volatile("" : "+v"(tid)); const int lane = tid & 63; (void)lane
#if defined(__HIP_DEVICE_COMPILE__)
    typedef const __attribute__((address_space(4))) unsigned char* kptr_t;
#define KP() ({ kptr_t kp_ = (kptr_t)__builtin_amdgcn_kernarg_segment_ptr(); asm volatile("" : "+s"(kp_)); kp_; })
#define KLD(off) (*(const __attribute__((address_space(4))) unsigned long long*)(KP() + (off)))
#define AIN(i) ((const float*)(const __attribute__((address_space(1))) float*)KLD(8 * (i)))
#define AOUT() ((float*)(__attribute__((address_space(1))) float*)KLD(192))
#define AWS() ((unsigned char*)(__attribute__((address_space(1))) unsigned char*)KLD(200))
#else
#define AIN(i) (args.in[i])
#define AOUT() (args.out)
#define AWS() (args.ws)
#endif
    unsigned* ctl = (unsigned*)(AWS() + WS_CTL);
    if (tid0 < 64) ((LAS unsigned*)(lds + LDS_MISC))[tid0] = 0u;
    __syncthreads();
    XcdBarrier bar; bar.bar = ctl + CW_BAR; bar.x = 0; bar.st = nullptr; bar.wv = wave0;
    bar = xcd_barrier_post(ctl + CW_BAR, (volatile LAS unsigned*)(lds + LDS_MISC)); bar.wv = wave0;
#ifndef PHMASK
#define PHMASK 0xFFF
#endif
#define EN(b) ((PHMASK >> (b)) & 1)

#define IN(k) true
#define SEAM(k) do { if (IN(k) && IN((k) + 1)) { xcd_barrier(bar); if (NREP(15) > 1) xcd_barrier(bar); } } while (0)

    if (EN(0) && IN(0)) { PHASE_TID(); for (int rep = 0; rep < NREP(0); ++rep) { p0_prologue(lds, gw, NGW, wave, lane, AIN(8), AIN(13), AIN(14), AIN(19), AIN(22), AIN(2), AIN(3), AWS()); if (rep + 1 < NREP(0)) xcd_barrier(bar); } }
    SEAM(0);
    if (EN(1) && IN(1)) { PHASE_TID(); p1_mod(gw, NGW, lane, AIN(17), AIN(18), AWS(), WS_MOD); if (NREP(1) > 1) p1_mod(gw, NGW, lane, AIN(17), AIN(18), AWS(), WS_MF); }
    SEAM(1);
#define WSLOC() unsigned char* ws = AWS(); const float* xp = AIN(0); const float* xs = AIN(1); bf16* XA = (bf16*)(ws + WS_XA); bf16* H = (bf16*)(ws + WS_H); bf16* PROJ = (bf16*)(ws + WS_PROJ); bf16* U = (bf16*)(ws + WS_U); \
    float* LOGA = (float*)(ws + WS_LOGA); bf16* ON = (bf16*)(ws + WS_ON); bf16* MB = (bf16*)(ws + WS_MB); bf16* ACT = (bf16*)(ws + WS_ACT); const float* modl = (const float*)(ws + WS_MOD) + (size_t)l * NBATCH * NMOD; \
    (void)xp; (void)xs; (void)XA; (void)H; (void)PROJ; (void)U; (void)LOGA; (void)ON; (void)MB; (void)ACT; (void)modl
    for (int l = 0; l < 2; ++l) {
        const int pb = 2 + 9 * l;
        if (EN(2) && IN(pb + 0)) {
            WSLOC();
            PHASE_TID();
            for (int rep = 0; rep < NREP(2); ++rep) norm_phase<false>(lds, gw, NGW, tid, lane, l, l == 0, xp, xs, XA, AIN(15) + l * D, modl, 0, 1, H, nullptr, nullptr, nullptr, nullptr);
        }
        SEAM(pb + 0);
        if (EN(3) && IN(pb + 1)) {
            WSLOC();
            PHASE_TID();
            pg8::Gemm g{H, (const bf16*)(ws + WS_WIN) + (size_t)l * NPROJ * D, MROWS, NPROJ, D, 0, 0}; pg8::StaticOrder S; S.init(MROWS, NPROJ, G, bx);
            pg8::EpiProj E{PROJ, NPROJ, (const float*)(ws + WS_ROPE), AIN(11), (float*)(ws + WS_LOGH), l, AIN(12) + l * 3 * 256};
            if (NREP(19) > 1) glr_phase(lds, vcu, G, tid, wave, lane, H, (const bf16*)(ws + WS_WG) + (size_t)l * 2 * 16 * D, AIN(9) + l * 16 * 512, AIN(10) + l * 512, LOGA);
            glr_phase(lds, vcu, G, tid, wave, lane, H, (const bf16*)(ws + WS_WG) + (size_t)l * 2 * 16 * D, AIN(9) + l * 16 * 512, AIN(10) + l * 512, LOGA);
            if (NREP(16) > 1 && NREP(3) == 1) { pg8::EpiNull EN_{(float*)(ws + WS_PROJ)}; pg8::gemm_phase<pg8::EpiNull, pg8::StaticOrder, GALIGN, GSP2>(lds, g, S, EN_, wave); xcd_barrier(bar); }
            for (int rep = 0; rep < NREP(3); ++rep) { pg8::gemm_phase<pg8::EpiProj, pg8::StaticOrder, GALIGN, GSP2>(lds, g, S, E, wave); if (rep + 1 < NREP(3)) xcd_barrier(bar); }
        }
        SEAM(pb + 1);
        if (EN(4) && IN(pb + 2)) {
            WSLOC();
            PHASE_TID();
            for (int rep = 0; rep < NREP(4); ++rep) { rec_phase(lds, tid, wave, lane, l, ctl + CW_QUEUE + 64 * l + 128 * rep, bar, PROJ, LOGA, (const float*)(ws + WS_LOGH), AIN(12), AIN(4), AIN(5), AIN(6), (float*)(ws + WS_DS), (float*)(ws + WS_DT), ON, AOUT()); if (rep + 1 < NREP(4)) xcd_barrier(bar); }
        }
        SEAM(pb + 2);
        if (EN(5) && IN(pb + 3)) {
            WSLOC();
            PHASE_TID();
            for (int rep = 0; rep < NREP(5); ++rep) {
                pg8::Gemm g{ON, (const bf16*)(ws + WS_WBR) + (size_t)(l * 3) * D * 1024, TP, D, 1024, (size_t)MROWS * 1024, (size_t)D * 1024}; pg8::SegOrder S; S.init(TP, D, G, bx);
                pg8::EpiBranch3 E{PROJ + MG_COL, NPROJ, MB};
                pg8::gemm_phase<pg8::EpiBranch3, pg8::SegOrder, GALIGN, GSP2>(lds, g, S, E, wave);
            }
            { __syncthreads();
              if (NREP(18) > 1) sgemm_phase<1>(lds, vcu, G, tid, wave, lane, ON, (size_t)MROWS * 1024, (const bf16*)(ws + WS_WBR) + (size_t)(l * 3) * D * 1024, (size_t)D * 1024, 1024, nullptr, nullptr, nullptr, PROJ + MG_COL, MB);
              sgemm_phase<1>(lds, vcu, G, tid, wave, lane, ON, (size_t)MROWS * 1024, (const bf16*)(ws + WS_WBR) + (size_t)(l * 3) * D * 1024, (size_t)D * 1024, 1024, nullptr, nullptr, nullptr, PROJ + MG_COL, MB); }
        }
        SEAM(pb + 3);
        if (EN(6) && IN(pb + 4)) {
            WSLOC();
            PHASE_TID();
            pg8::Gemm g{MB, (const bf16*)(ws + WS_WOUT) + (size_t)l * D * D, TP, D, D, 0, 0}; pg8::StaticOrder S; S.init(TP, D, G, bx);
            pg8::EpiResid E{l == 0 ? xp : nullptr, l == 0 ? xs : nullptr, XA, XA, modl + 2 * D};
            if (NREP(6) > 1) { pg8::EpiResid E2{l == 0 ? xp : nullptr, l == 0 ? xs : nullptr, XA, (bf16*)(ws + WS_MF), modl + 2 * D}; pg8::gemm_phase<pg8::EpiResid, pg8::StaticOrder, GALIGN, GSP2>(lds, g, S, E2, wave); }
            pg8::gemm_phase<pg8::EpiResid, pg8::StaticOrder, GALIGN, GSP2>(lds, g, S, E, wave);
            { __syncthreads();
              if (NREP(18) > 1) sgemm_phase<0>(lds, vcu, G, tid, wave, lane, MB, 0, (const bf16*)(ws + WS_WOUT) + (size_t)l * D * D, 0, D, XA, l == 0 ? xs : nullptr, modl + 2 * D, nullptr, (bf16*)(ws + WS_MF));
              sgemm_phase<0>(lds, vcu, G, tid, wave, lane, MB, 0, (const bf16*)(ws + WS_WOUT) + (size_t)l * D * D, 0, D, XA, l == 0 ? xs : nullptr, modl + 2 * D, nullptr, nullptr); }
        }
        SEAM(pb + 4);
        if (EN(7) && IN(pb + 5)) {
            WSLOC();
            PHASE_TID();
            for (int rep = 0; rep < NREP(7); ++rep) norm_phase<false>(lds, gw, NGW, tid, lane, l, 0, xp, xs, XA, AIN(16) + l * D, modl, 3, 4, H, nullptr, nullptr, nullptr, nullptr);
        }
        SEAM(pb + 5);
        if (EN(8) && IN(pb + 6)) {
            WSLOC();
            PHASE_TID();
            pg8::Gemm g{H, (const bf16*)(ws + WS_WUP) + (size_t)l * NUP * D, MROWS, NUP, D, 0, 0}; pg8::StaticOrder S; S.init(MROWS, NUP, G, bx);
            pg8::EpiUpConv E{ACT, AIN(20) + (size_t)l * 3 * NUP, AIN(21) + (size_t)l * NUP, AIN(7) + (size_t)l * 128 * 2 * NUP, (float*)(ws + WS_UH), AOUT() + O_SCONV + (size_t)l * 128 * 2 * NUP};
            for (int rep = 0; rep < NREP(8); ++rep) pg8::gemm_phase<pg8::EpiUpConv, pg8::StaticOrder, GALIGN, GSP2>(lds, g, S, E, wave);
        }
        SEAM(pb + 6);
        if (EN(9) && IN(pb + 7)) {
            WSLOC();
            PHASE_TID();
            conv_fix_phase(vcu * NWAVES * 64 + tid, G * NWAVES * 64, l, (const float*)(ws + WS_UH), AIN(20) + (size_t)l * 3 * NUP, AIN(21) + (size_t)l * NUP, ACT, AOUT());
        }
        SEAM(pb + 7);
        if (EN(10) && IN(pb + 8)) {
            WSLOC();
            PHASE_TID();
            pg8::Gemm g{ACT, (const bf16*)(ws + WS_WDN) + (size_t)l * D * DFF, TP, D, DFF, 0, 0}; pg8::StaticOrder S; S.init(TP, D, G, bx);
            pg8::EpiResid E{nullptr, nullptr, XA, XA, modl + 5 * D};
            if (NREP(10) > 1) { pg8::EpiResid E2{nullptr, nullptr, XA, (bf16*)(ws + WS_MF), modl + 5 * D}; pg8::gemm_phase<pg8::EpiResid, pg8::StaticOrder, GALIGN, GSP2>(lds, g, S, E2, wave); }
            pg8::gemm_phase<pg8::EpiResid, pg8::StaticOrder, GALIGN, GSP2>(lds, g, S, E, wave);
            { __syncthreads();
              if (NREP(18) > 1) sgemm_phase<0>(lds, vcu, G, tid, wave, lane, ACT, 0, (const bf16*)(ws + WS_WDN) + (size_t)l * D * DFF, 0, DFF, XA, nullptr, modl + 5 * D, nullptr, (bf16*)(ws + WS_MF));
              sgemm_phase<0>(lds, vcu, G, tid, wave, lane, ACT, 0, (const bf16*)(ws + WS_WDN) + (size_t)l * D * DFF, 0, DFF, XA, nullptr, modl + 5 * D, nullptr, nullptr); }
        }
        SEAM(pb + 8);
    }
    if (EN(11) && IN(20)) { PHASE_TID(); final_norm_phase(gw, NGW, lane, (const bf16*)(AWS() + WS_XA), AIN(23), AOUT()); }
#undef IN
#undef SEAM
}

extern "C" void kernel_launch(void* const* d_in, const int* in_sizes, int n_in, void* d_out, int out_size, void* d_ws, size_t ws_size, hipStream_t stream) {
    static int grid = 0;
    if (grid == 0) {
        if (n_in != 24 || ws_size < WS_END) { fprintf(stderr, "kernel_launch: unexpected n_in %d / ws_size %zu (need %zu)\n", n_in, ws_size, (size_t)WS_END); grid = -1; return; }
        int dev = 0, cus = 0, per_cu = 0;
        if (hipGetDevice(&dev) != hipSuccess || hipDeviceGetAttribute(&cus, hipDeviceAttributeMultiprocessorCount, dev) != hipSuccess) { grid = -1; return; }
        if (hipFuncSetAttribute((const void*)mega, hipFuncAttributeMaxDynamicSharedMemorySize, LDS_BYTES) != hipSuccess) { fprintf(stderr, "kernel_launch: hipFuncSetAttribute failed\n"); grid = -1; return; }
        if (hipOccupancyMaxActiveBlocksPerMultiprocessor(&per_cu, (const void*)mega, NWAVES * 64, LDS_BYTES) != hipSuccess || per_cu < 1)
            fprintf(stderr, "kernel_launch: occupancy query reports %d blocks per CU\n", per_cu);
        (void)hipGetLastError();
        grid = cus;
    }
    if (grid < 0) return;
    (void)hipMemsetAsync((char*)d_ws + WS_CTL, 0, CTL_BYTES, stream);
    Args a{};
    for (int i = 0; i < 24; ++i) a.in[i] = (const float*)d_in[i];
    a.out = (float*)d_out; a.ws = (unsigned char*)d_ws;
#if MK_ONE_LAUNCH
    a.ph_lo = 0; a.ph_hi = NPH;
    hipLaunchKernelGGL(mega, dim3(grid), dim3(NWAVES * 64), LDS_BYTES, stream, a);
#else
    for (int p = 0; p < NPH; ++p) { a.ph_lo = p; a.ph_hi = p + 1; hipLaunchKernelGGL(mega, dim3(grid), dim3(NWAVES * 64), LDS_BYTES, stream, a); }
#endif
    const hipError_t le = hipPeekAtLastError();
    if (le != hipSuccess) fprintf(stderr, "kernel_launch: launch failed: %s\n", hipGetErrorName(le));
}
```

```cpp
#include <hip/hip_runtime.h>
#include <cstdio>
#include <cstdint>
#ifndef REPMASK
#define REPMASK 0
#endif
#define NREP(b) (((REPMASK >> (b)) & 1) ? 2 : 1)
namespace pg8 {
#define PG8_LAS __attribute__((address_space(3)))
typedef unsigned short bf16_t;
typedef short bf16x8 __attribute__((ext_vector_type(8)));
typedef float f32x4 __attribute__((ext_vector_type(4)));
typedef unsigned u32x4 __attribute__((ext_vector_type(4)));
constexpr int BM = 256, BK = 64, HALF = 128, HTB = HALF * BK * 2  , STAGE_BYTES = 8 * HTB, NXCD = 8, WGM = 8;

__host__ __device__ __forceinline__ int lds_byte(int r, int c) { const int st = (r >> 4) * 2 + (c >> 5), rr = r & 15, cc = c & 31, ob = rr * 64 + cc * 2; return st * 1024 + (ob ^ (((ob >> 9) & 1) << 5)); }
__host__ __device__ __forceinline__ void stage_rc(int b, int& R, int& C) { const int st = b / 1024, sb = b % 1024, swz = sb ^ (((sb >> 9) & 1) << 5); R = (st >> 1) * 16 + swz / 64; C = (st & 1) * 32 + (swz % 64) / 2; }
__host__ __device__ __forceinline__ int perm32(int rho) { const int n = rho >> 4, i = rho & 15; return 8 * (i >> 2) + 4 * n + (i & 3); }

struct Unit { int pm, pn, seg; };
struct Gemm { const bf16_t* A; const bf16_t* Bt; int M, N, K; size_t a_seg, b_seg; };

struct StaticOrder {
    int nM, nN, nwg, G, c;
    __host__ __device__ __forceinline__ void init(int M, int N, int G_, int c_) { nM = M / BM; nN = N / BM; nwg = nM * nN; G = G_; c = c_; }
    __host__ __device__ __forceinline__ bool next(int i, Unit& u) const {
        const long L = (long)i * G + c; if (L >= nwg) return false;
        int wgid = (int)L; { const int q = nwg / NXCD, r = nwg % NXCD, xcd = wgid % NXCD, off = wgid / NXCD; wgid = (xcd < r ? xcd * (q + 1) : r * (q + 1) + (xcd - r) * q) + off; }
        const int nig = WGM * nN, gid = wgid / nig, fm = gid * WGM, gsz = (nM - fm) < WGM ? (nM - fm) : WGM;
        u.pm = fm + ((wgid % nig) % gsz); u.pn = (wgid % nig) / gsz; u.seg = 0; return true;
    }
    __device__ __forceinline__ void a_ready(const Unit&) const {}
    __device__ __forceinline__ void done(const Unit&) const {}
};

__device__ __forceinline__ unsigned cvt_pk_bf16(float lo, float hi) { unsigned r; asm volatile("v_cvt_pk_bf16_f32 %0, %1, %2" : "=v"(r) : "v"(lo), "v"(hi)); return r; }
typedef float f32x2 __attribute__((ext_vector_type(2)));
typedef unsigned u32x2 __attribute__((ext_vector_type(2)));
__device__ __forceinline__ float fast_sigmoid(float x) { return __builtin_amdgcn_rcpf(1.0f + __builtin_amdgcn_exp2f(-1.44269504f * x)); }
__device__ __forceinline__ float bf_lo(unsigned u) { return __uint_as_float(u << 16); }
__device__ __forceinline__ float bf_hi(unsigned u) { return __uint_as_float(u & 0xffff0000u); }

struct EpiBf16 {
    static constexpr bool PERM = true, AFTER_DRAIN = false, MULTISEG = false, AROWPERM = false;
    bf16_t* O; int ldc;
    __device__ __forceinline__ void operator()(const f32x4 (&acc)[2][2][4][2], const Unit& u, int wr, int wc, int fr, int fq) const {
        const int row0 = u.pm * BM + wr * 64 + fr, col0 = u.pn * BM + wc * 32 + 8 * fq;
#pragma unroll
        for (int ai = 0; ai < 2; ++ai)
#pragma unroll
            for (int m = 0; m < 4; ++m) { bf16_t* rowp = O + (size_t)(row0 + ai * HALF + m * 16) * ldc + col0;
#pragma unroll
                for (int bj = 0; bj < 2; ++bj) { const f32x4 v0 = acc[ai][bj][m][0], v1 = acc[ai][bj][m][1];
                    u32x4 w; w.x = cvt_pk_bf16(v0[0], v0[1]); w.y = cvt_pk_bf16(v0[2], v0[3]); w.z = cvt_pk_bf16(v1[0], v1[1]); w.w = cvt_pk_bf16(v1[2], v1[3]);
                    *(u32x4*)(rowp + bj * HALF) = w; } }
    }
};
struct EpiBranch {
    static constexpr bool PERM = false, AFTER_DRAIN = false, MULTISEG = false, AROWPERM = false;
    const bf16_t* gate; int ldg; float* mf; bf16_t* mb; int mode;
    __device__ __forceinline__ void operator()(const f32x4 (&acc)[2][2][4][2], const Unit& u, int wr, int wc, int fr, int fq) const {
        const int row0 = u.pm * BM + wr * 64 + fr, col0 = u.pn * BM + wc * 32 + 4 * fq;
#pragma unroll
        for (int ai = 0; ai < 2; ++ai)
#pragma unroll
            for (int m = 0; m < 4; ++m) { const int r = row0 + ai * HALF + m * 16;
#pragma unroll
                for (int bj = 0; bj < 2; ++bj)
#pragma unroll
                    for (int n = 0; n < 2; ++n) { const int c = col0 + bj * HALF + n * 16;
                        const u32x2 g2 = *(const u32x2*)(gate + (size_t)r * ldg + c);
                        f32x4 v = acc[ai][bj][m][n];
                        v[0] *= fast_sigmoid(bf_lo(g2.x)); v[1] *= fast_sigmoid(bf_hi(g2.x)); v[2] *= fast_sigmoid(bf_lo(g2.y)); v[3] *= fast_sigmoid(bf_hi(g2.y));
                        float* mp = mf + (size_t)r * 2048 + c;
                        if (mode == 0) { *(f32x4*)mp = v; }
                        else { v += *(const f32x4*)mp;
                            if (mode == 1) *(f32x4*)mp = v;
                            else { u32x2 w; w.x = cvt_pk_bf16(v[0], v[1]); w.y = cvt_pk_bf16(v[2], v[3]); *(u32x2*)(mb + (size_t)r * 2048 + c) = w; } } }
                asm volatile("" ::: "memory"); }
    }
};
struct EpiNull { static constexpr bool PERM = true, AFTER_DRAIN = false, MULTISEG = false, AROWPERM = false;
    float* sink; __device__ __forceinline__ void operator()(const f32x4 (&acc)[2][2][4][2], const Unit& u, int wr, int wc, int fr, int fq) const { f32x4 t = {0.f, 0.f, 0.f, 0.f};
#pragma unroll
        for (int a = 0; a < 2; ++a)
#pragma unroll
            for (int b = 0; b < 2; ++b)
#pragma unroll
                for (int m = 0; m < 4; ++m)
#pragma unroll
                    for (int n = 0; n < 2; ++n) t += acc[a][b][m][n];
        if (t[0] + t[1] + t[2] + t[3] == 1.2345e30f) sink[0] = 1.f;
#if REPMASK & 0x20000
        { bf16_t* O = (bf16_t*)sink; const int row0 = u.pm * BM + wr * 64 + fr, col0 = u.pn * BM + wc * 32 + 8 * fq;
#pragma unroll
          for (int ai = 0; ai < 2; ++ai)
#pragma unroll
            for (int m = 0; m < 4; ++m) { const f32x4 v0 = acc[ai][0][m][0], v1 = acc[ai][0][m][1];
                u32x4 w; w.x = cvt_pk_bf16(v0[0], v0[1]); w.y = cvt_pk_bf16(v0[2], v0[3]); w.z = cvt_pk_bf16(v1[0], v1[1]); w.w = cvt_pk_bf16(v1[2], v1[3]);
                __builtin_nontemporal_store(w, (u32x4*)(O + (size_t)(row0 + ai * HALF + m * 16) * 15360 + col0)); } }
#endif
    } };
struct EpiProj {
    static constexpr bool PERM = true, AFTER_DRAIN = false, MULTISEG = false, AROWPERM = false;
    bf16_t* O; int ldc; const float* rope; const float* lbl; float* logh; int layer; const float* hnorm;
    __device__ __forceinline__ void operator()(const f32x4 (&acc)[2][2][4][2], const Unit& u, int wr, int wc, int fr, int fq) const {
        const int pn = u.pn;
        const bool swish = (pn >= 8 && pn < 12) || (pn >= 20 && pn < 24) || (pn >= 32 && pn < 36) || pn == 24 || pn == 25;
        const int mode = pn < 4 ? 1 : ((pn == 12 || pn == 13) ? 2 : (swish ? 3 : ((pn == 26 || pn == 27) ? 4 : 0)));
        if (mode == 1) run<1, false>(acc, u, wr, wc, fr, fq);
        else if (mode == 2) run<2, false>(acc, u, wr, wc, fr, fq);
        else if (mode == 3) run<3, false>(acc, u, wr, wc, fr, fq);
        else if (mode == 4) run<4, false>(acc, u, wr, wc, fr, fq);
        else if (pn >= 36) run<0, true>(acc, u, wr, wc, fr, fq);
        else run<0, false>(acc, u, wr, wc, fr, fq);
    }
    template <int MODE, bool PLAIN>
    __device__ __forceinline__ void run(const f32x4 (&acc)[2][2][4][2], const Unit& u, int wr, int wc, int fr, int fq) const {
        const int row0 = u.pm * BM + wr * 64 + fr, col0 = u.pn * BM + wc * 32 + 8 * fq; const int pn = u.pn;
        const float ks = (pn == 2 || pn == 3 || MODE == 2) ? 0.08838834764831845f : 1.0f;
        float lb[2][8];
        if (MODE == 3) {
#pragma unroll
            for (int bj = 0; bj < 2; ++bj)
#pragma unroll
                for (int e = 0; e < 8; ++e) lb[bj][e] = 1.0f;
            if (pn != 24 && pn != 25) {
#pragma unroll
                for (int bj = 0; bj < 2; ++bj) { const float* hp = hnorm + ((pn - 8) / 12) * 256 + ((bj * HALF + wc * 32 + 8 * fq) & 255); const f32x4 h0 = *(const f32x4*)hp, h1 = *(const f32x4*)(hp + 4);
                    lb[bj][0] = h0.x; lb[bj][1] = h0.y; lb[bj][2] = h0.z; lb[bj][3] = h0.w; lb[bj][4] = h1.x; lb[bj][5] = h1.y; lb[bj][6] = h1.z; lb[bj][7] = h1.w; } } }
        if (MODE == 4) {
#pragma unroll
            for (int bj = 0; bj < 2; ++bj)
#pragma unroll
                for (int e = 0; e < 8; ++e) lb[bj][e] = 0.f;
            if (layer != 0) { f32x4 la_[4], lb_[4];
#pragma unroll
                for (int bj = 0; bj < 2; ++bj) { const int c = (pn - 26) * 256 + bj * HALF + wc * 32 + 8 * fq;
                    la_[2 * bj] = *(const f32x4*)(lbl + c); la_[2 * bj + 1] = *(const f32x4*)(lbl + c + 4); lb_[2 * bj] = *(const f32x4*)(lbl + 512 + c); lb_[2 * bj + 1] = *(const f32x4*)(lbl + 512 + c + 4); }
                asm volatile("" : "+v"(la_[0]), "+v"(la_[1]), "+v"(la_[2]), "+v"(la_[3]), "+v"(lb_[0]), "+v"(lb_[1]), "+v"(lb_[2]), "+v"(lb_[3]));
#pragma unroll
                for (int bj = 0; bj < 2; ++bj)
#pragma unroll
                    for (int e = 0; e < 8; ++e) lb[bj][e] = fast_sigmoid(lb_[2 * bj + (e >> 2)][e & 3] - la_[2 * bj + (e >> 2)][e & 3]); }
        }
#pragma unroll
        for (int ai = 0; ai < 2; ++ai) {
            f32x4 csA[4], snA[4];
            if (MODE == 1) {
#pragma unroll
                for (int m = 0; m < 4; ++m) { const int r = row0 + ai * HALF + m * 16; const int pidx = r < 8192 ? (r & 2047) : 2048 + ((r - 8192) & 3); const float* rp = rope + (size_t)pidx * 128 + 16 * wc + 4 * fq;
                    csA[m] = *(const f32x4*)rp; snA[m] = *(const f32x4*)(rp + 64); }
                asm volatile("" : "+v"(csA[0]), "+v"(csA[1]), "+v"(csA[2]), "+v"(csA[3]), "+v"(snA[0]), "+v"(snA[1]), "+v"(snA[2]), "+v"(snA[3])); }
#pragma unroll
            for (int m = 0; m < 4; ++m) { const int r = row0 + ai * HALF + m * 16; bf16_t* rowp = O + (size_t)r * ldc + col0;
#pragma unroll
                for (int bj = 0; bj < 2; ++bj) { f32x4 v0 = acc[ai][bj][m][0], v1 = acc[ai][bj][m][1];
                    if (MODE == 1) { const f32x4 cs4 = csA[m], sn4 = snA[m]; const f32x4 y1 = (v0 * cs4 - v1 * sn4) * ks, y2 = (v0 * sn4 + v1 * cs4) * ks; v0 = y1; v1 = y2; }
                    else if (MODE == 2) { v0 = v0 * ks; v1 = v1 * ks; }
                    else if (MODE == 3) {
#pragma unroll
                        for (int e = 0; e < 4; ++e) { v0[e] = v0[e] * fast_sigmoid(v0[e]); v1[e] = v1[e] * fast_sigmoid(v1[e]); }
                        v0 = v0 * (f32x4){lb[bj][0], lb[bj][1], lb[bj][2], lb[bj][3]}; v1 = v1 * (f32x4){lb[bj][4], lb[bj][5], lb[bj][6], lb[bj][7]}; }
                    else if (MODE == 4) { f32x4 g0, g1;
#pragma unroll
                        for (int e = 0; e < 4; ++e) {
                            { const float t = __builtin_amdgcn_exp2f(-1.44269504f * v0[e]), sg = __builtin_amdgcn_rcpf(1.0f + t), l_ = lb[bj][e];
                              g0[e] = __builtin_amdgcn_logf(fmaxf(l_ + (1.0f - l_) * sg, 1e-37f)); v0[e] = (1.0f - l_) * (t < 1e30f ? t * sg : 1.0f); }
                            { const float t = __builtin_amdgcn_exp2f(-1.44269504f * v1[e]), sg = __builtin_amdgcn_rcpf(1.0f + t), l_ = lb[bj][4 + e];
                              g1[e] = __builtin_amdgcn_logf(fmaxf(l_ + (1.0f - l_) * sg, 1e-37f)); v1[e] = (1.0f - l_) * (t < 1e30f ? t * sg : 1.0f); } }
                        float* lp = logh + (size_t)r * 512 + (pn - 26) * 256 + bj * HALF + wc * 32 + 8 * fq; *(f32x4*)lp = g0; *(f32x4*)(lp + 4) = g1; }
                    u32x4 w; w.x = cvt_pk_bf16(v0[0], v0[1]); w.y = cvt_pk_bf16(v0[2], v0[3]); w.z = cvt_pk_bf16(v1[0], v1[1]); w.w = cvt_pk_bf16(v1[2], v1[3]);
                    if (!PLAIN) __builtin_nontemporal_store(w, (u32x4*)(rowp + bj * HALF)); else *(u32x4*)(rowp + bj * HALF) = w; } } }
    }
};
__device__ __forceinline__ float dpp_shr1(float x) { return __builtin_bit_cast(float, __builtin_amdgcn_update_dpp(0, __builtin_bit_cast(int, x), 0x111, 0xf, 0xf, true)); }
struct EpiUpConv {
    static constexpr bool PERM = true, AFTER_DRAIN = false, MULTISEG = false, AROWPERM = true;
    bf16_t* ACT; const float* cw; const float* cb; const float* sconv; float* UH; float* sconv_out;
    __device__ __forceinline__ void operator()(const f32x4 (&acc)[2][2][4][2], const Unit& u, int wr, int wc, int fr, int fq) const {
        const int pn = u.pn, pm = u.pm; const bool prm = pm < 32;
        const int tok0 = 128 * wr + 8 * fr;
        u32x2 y0p[8];
#pragma unroll
        for (int n = 0; n < 2; ++n) {
            const int cl = 128 * pn + 32 * wc + 8 * fq + 4 * n;
            const f32x4 wa0 = *(const f32x4*)(cw + cl), wa1 = *(const f32x4*)(cw + 11264 + cl), wa2 = *(const f32x4*)(cw + 22528 + cl), ba = *(const f32x4*)(cb + cl);
            const f32x4 wb0 = *(const f32x4*)(cw + 5632 + cl), wb1 = *(const f32x4*)(cw + 11264 + 5632 + cl), wb2 = *(const f32x4*)(cw + 22528 + 5632 + cl), bb = *(const f32x4*)(cb + 5632 + cl);
            f32x4 a2, a1, b2, b1;
            f32x4 sc2[4];
#pragma unroll
            for (int i = 0; i < 4; ++i) sc2[i] = (f32x4){0.f, 0.f, 0.f, 0.f};
            if (prm) {
#pragma unroll
                for (int e = 0; e < 4; ++e) { a2[e] = dpp_shr1(acc[1][0][2][n][e]); a1[e] = dpp_shr1(acc[1][0][3][n][e]); b2[e] = dpp_shr1(acc[1][1][2][n][e]); b1[e] = dpp_shr1(acc[1][1][3][n][e]); }
                if (fr == 0 || fr == 15) {
                    float* uh = UH + ((size_t)pm * 8 + 4 * wr + (fr == 15 ? 2 : 0)) * 11264 + cl;
                    const bool hi = fr == 15;
                    *(f32x4*)uh = hi ? acc[1][0][2][n] : acc[0][0][0][n]; *(f32x4*)(uh + 5632) = hi ? acc[1][1][2][n] : acc[0][1][0][n];
                    *(f32x4*)(uh + 11264) = hi ? acc[1][0][3][n] : acc[0][0][1][n]; *(f32x4*)(uh + 11264 + 5632) = hi ? acc[1][1][3][n] : acc[0][1][1][n]; }
            } else {
                const float* sp = sconv + (size_t)((256 * (pm - 32) + tok0) >> 2) * 2 * 11264 + cl;
                a2 = *(const f32x4*)sp; b2 = *(const f32x4*)(sp + 5632); a1 = *(const f32x4*)(sp + 11264); b1 = *(const f32x4*)(sp + 11264 + 5632);
                const float* sq = sp + 2 * 11264;
                sc2[0] = *(const f32x4*)sq; sc2[1] = *(const f32x4*)(sq + 5632); sc2[2] = *(const f32x4*)(sq + 11264); sc2[3] = *(const f32x4*)(sq + 11264 + 5632);
            }
#pragma unroll
            for (int j = 0; j < 8; ++j) {
                const int ai = j >> 2, m = j & 3;
                if (!prm && j == 4) { a2 = sc2[0]; b2 = sc2[1]; a1 = sc2[2]; b1 = sc2[3]; }
                const f32x4 a0 = acc[ai][0][m][n], b0 = acc[ai][1][m][n];
                const f32x4 ca = ba + wa0 * a2 + wa1 * a1 + wa2 * a0, cbv = bb + wb0 * b2 + wb1 * b1 + wb2 * b0;
                f32x4 y;
#pragma unroll
                for (int e = 0; e < 4; ++e) y[e] = ca[e] * fast_sigmoid(ca[e]) * cbv[e];
                if (n == 0) { y0p[j].x = cvt_pk_bf16(y[0], y[1]); y0p[j].y = cvt_pk_bf16(y[2], y[3]); }
                else if (!(prm && fr == 0 && j < 2)) { u32x4 w; w.x = y0p[j].x; w.y = y0p[j].y; w.z = cvt_pk_bf16(y[0], y[1]); w.w = cvt_pk_bf16(y[2], y[3]);
                    *(u32x4*)(ACT + (size_t)(256 * pm + tok0 + j) * 5632 + cl - 4) = w; }
                if (!prm && (j & 3) >= 2) {
                    float* so = sconv_out + ((size_t)(((256 * (pm - 32) + tok0) >> 2) + (j >> 2)) * 2 + ((j & 3) - 2)) * 11264 + cl;
                    *(f32x4*)so = a0; *(f32x4*)(so + 5632) = b0; }
                a2 = a1; a1 = a0; b2 = b1; b1 = b0;
                asm volatile("" ::: "memory");
            }
            asm volatile("" ::: "memory");
        }
    }
};
struct EpiBranch3 {
    static constexpr bool PERM = true, AFTER_DRAIN = false, MULTISEG = true, AROWPERM = false;
    const bf16_t* gate; int ldg; bf16_t* mb;
    __device__ __forceinline__ void operator()(f32x4 (&acc)[2][2][4][2], const Unit& u, int wr, int wc, int fr, int fq) const {
        const int row0 = u.pm * BM + wr * 64 + fr, col0 = u.pn * BM + wc * 32 + 8 * fq;
#pragma unroll
        for (int ai = 0; ai < 2; ++ai) {
            if (u.seg < 2) {
                u32x4 ga[4][2], gb[4][2];
#pragma unroll
                for (int m = 0; m < 4; ++m)
#pragma unroll
                    for (int bj = 0; bj < 2; ++bj) { const bf16_t* gp = gate + (size_t)(row0 + ai * HALF + m * 16) * ldg + u.seg * 2048 + col0 + bj * HALF; ga[m][bj] = *(const u32x4*)gp; gb[m][bj] = *(const u32x4*)(gp + 2048); }
                asm volatile("" : "+v"(ga[0][0]), "+v"(ga[0][1]), "+v"(ga[1][0]), "+v"(ga[1][1]), "+v"(ga[2][0]), "+v"(ga[2][1]), "+v"(ga[3][0]), "+v"(ga[3][1]),
                                  "+v"(gb[0][0]), "+v"(gb[0][1]), "+v"(gb[1][0]), "+v"(gb[1][1]), "+v"(gb[2][0]), "+v"(gb[2][1]), "+v"(gb[3][0]), "+v"(gb[3][1]));
#pragma unroll
                for (int m = 0; m < 4; ++m)
#pragma unroll
                    for (int bj = 0; bj < 2; ++bj) { f32x4 v0 = acc[ai][bj][m][0], v1 = acc[ai][bj][m][1];
#pragma unroll
                        for (int e = 0; e < 4; ++e) { const float a0 = bf_lo(ga[m][bj][e]), a1 = bf_hi(ga[m][bj][e]), b0 = fmaxf(bf_lo(gb[m][bj][e]), -60.f), b1 = fmaxf(bf_hi(gb[m][bj][e]), -60.f);
                            const float r0 = (1.0f + __builtin_amdgcn_exp2f(-1.44269504f * b0)) * __builtin_amdgcn_rcpf(1.0f + __builtin_amdgcn_exp2f(-1.44269504f * a0));
                            const float r1 = (1.0f + __builtin_amdgcn_exp2f(-1.44269504f * b1)) * __builtin_amdgcn_rcpf(1.0f + __builtin_amdgcn_exp2f(-1.44269504f * a1));
                            if (e < 2) { v0[2 * e] *= r0; v0[2 * e + 1] *= r1; } else { v1[2 * (e - 2)] *= r0; v1[2 * (e - 2) + 1] *= r1; } }
                        acc[ai][bj][m][0] = v0; acc[ai][bj][m][1] = v1; }
            } else {
                u32x4 ga[4][2];
#pragma unroll
                for (int m = 0; m < 4; ++m)
#pragma unroll
                    for (int bj = 0; bj < 2; ++bj) ga[m][bj] = *(const u32x4*)(gate + (size_t)(row0 + ai * HALF + m * 16) * ldg + u.seg * 2048 + col0 + bj * HALF);
                asm volatile("" : "+v"(ga[0][0]), "+v"(ga[0][1]), "+v"(ga[1][0]), "+v"(ga[1][1]), "+v"(ga[2][0]), "+v"(ga[2][1]), "+v"(ga[3][0]), "+v"(ga[3][1]));
#pragma unroll
                for (int m = 0; m < 4; ++m)
#pragma unroll
                    for (int bj = 0; bj < 2; ++bj) { f32x4 v0 = acc[ai][bj][m][0], v1 = acc[ai][bj][m][1];
#pragma unroll
                        for (int e = 0; e < 4; ++e) { const float s0 = fast_sigmoid(bf_lo(ga[m][bj][e])), s1 = fast_sigmoid(bf_hi(ga[m][bj][e]));
                            if (e < 2) { v0[2 * e] *= s0; v0[2 * e + 1] *= s1; } else { v1[2 * (e - 2)] *= s0; v1[2 * (e - 2) + 1] *= s1; } }
                        u32x4 w; w.x = cvt_pk_bf16(v0[0], v0[1]); w.y = cvt_pk_bf16(v0[2], v0[3]); w.z = cvt_pk_bf16(v1[0], v1[1]); w.w = cvt_pk_bf16(v1[2], v1[3]);
                        *(u32x4*)(mb + (size_t)(row0 + ai * HALF + m * 16) * 2048 + col0 + bj * HALF) = w; }
            }
            asm volatile("" ::: "memory"); }
    }
};
struct SegOrder : StaticOrder {
    __host__ __device__ __forceinline__ bool next(int i, Unit& u) const { const int it = i / 3; if (!StaticOrder::next(it, u)) return false; u.seg = i - 3 * it; return true; }
};
struct EpiResid {
    static constexpr bool PERM = true, AFTER_DRAIN = false, MULTISEG = false, AROWPERM = false;
    const float* xin_p; const float* xin_s; const bf16_t* xin_b; bf16_t* xout; const float* gvec;
    __device__ __forceinline__ void operator()(const f32x4 (&acc)[2][2][4][2], const Unit& u, int wr, int wc, int fr, int fq) const {
        const int row0 = u.pm * BM + wr * 64 + fr, col0 = u.pn * BM + wc * 32 + 8 * fq;
        f32x4 gq[2][2];
        { const float* gr = gvec + (size_t)(u.pm >> 3) * 12288 + col0;
#pragma unroll
            for (int bj = 0; bj < 2; ++bj) { gq[bj][0] = *(const f32x4*)(gr + bj * HALF); gq[bj][1] = *(const f32x4*)(gr + bj * HALF + 4); } }
#define RESID_OUT(m_, bj_, x0_, x1_) do { const int r = row0 + ai * HALF + (m_) * 16, c = col0 + (bj_) * HALF; \
            const f32x4 g0 = gq[bj_][0], g1 = gq[bj_][1]; \
            const f32x4 o0 = (x0_) + g0 * acc[ai][bj_][m_][0], o1 = (x1_) + g1 * acc[ai][bj_][m_][1]; \
            u32x4 w; w.x = cvt_pk_bf16(o0[0], o0[1]); w.y = cvt_pk_bf16(o0[2], o0[3]); w.z = cvt_pk_bf16(o1[0], o1[1]); w.w = cvt_pk_bf16(o1[2], o1[3]); \
            *(u32x4*)(xout + (size_t)r * 2048 + c) = w; } while (0)
        if (xin_p) {
#pragma unroll
            for (int ai = 0; ai < 2; ++ai)
#pragma unroll
                for (int mp = 0; mp < 2; ++mp) {
                    f32x4 xa[2][2][2];
#pragma unroll
                    for (int mm = 0; mm < 2; ++mm)
#pragma unroll
                        for (int bj = 0; bj < 2; ++bj) { const int r = row0 + ai * HALF + (2 * mp + mm) * 16, c = col0 + bj * HALF;
                            const float* xr = r < 8192 ? xin_p + (size_t)r * 2048 : xin_s + (size_t)(r - 8192) * 2048; xa[mm][bj][0] = *(const f32x4*)(xr + c); xa[mm][bj][1] = *(const f32x4*)(xr + c + 4); }
                    asm volatile("" : "+v"(xa[0][0][0]), "+v"(xa[0][0][1]), "+v"(xa[0][1][0]), "+v"(xa[0][1][1]), "+v"(xa[1][0][0]), "+v"(xa[1][0][1]), "+v"(xa[1][1][0]), "+v"(xa[1][1][1]));
#pragma unroll
                    for (int mm = 0; mm < 2; ++mm) { RESID_OUT(2 * mp + mm, 0, xa[mm][0][0], xa[mm][0][1]); RESID_OUT(2 * mp + mm, 1, xa[mm][1][0], xa[mm][1][1]); }
                    asm volatile("" ::: "memory"); }
        } else {
            u32x4 xb[2][4][2];
#pragma unroll
            for (int ai = 0; ai < 2; ++ai)
#pragma unroll
                for (int m = 0; m < 4; ++m)
#pragma unroll
                    for (int bj = 0; bj < 2; ++bj) xb[ai][m][bj] = *(const u32x4*)(xin_b + (size_t)(row0 + ai * HALF + m * 16) * 2048 + col0 + bj * HALF);
            asm volatile("" : "+v"(xb[0][0][0]), "+v"(xb[0][0][1]), "+v"(xb[0][1][0]), "+v"(xb[0][1][1]), "+v"(xb[0][2][0]), "+v"(xb[0][2][1]), "+v"(xb[0][3][0]), "+v"(xb[0][3][1]),
                              "+v"(xb[1][0][0]), "+v"(xb[1][0][1]), "+v"(xb[1][1][0]), "+v"(xb[1][1][1]), "+v"(xb[1][2][0]), "+v"(xb[1][2][1]), "+v"(xb[1][3][0]), "+v"(xb[1][3][1]));
#pragma unroll
            for (int ai = 0; ai < 2; ++ai) {
#pragma unroll
                for (int m = 0; m < 4; ++m) {
                    { const u32x4 t = xb[ai][m][0]; const f32x4 x0 = {bf_lo(t.x), bf_hi(t.x), bf_lo(t.y), bf_hi(t.y)}, x1 = {bf_lo(t.z), bf_hi(t.z), bf_lo(t.w), bf_hi(t.w)}; RESID_OUT(m, 0, x0, x1); }
                    { const u32x4 t = xb[ai][m][1]; const f32x4 x0 = {bf_lo(t.x), bf_hi(t.x), bf_lo(t.y), bf_hi(t.y)}, x1 = {bf_lo(t.z), bf_hi(t.z), bf_lo(t.w), bf_hi(t.w)}; RESID_OUT(m, 1, x0, x1); } }
                asm volatile("" ::: "memory"); }
        }
#undef RESID_OUT
    }
};

template <class Epi, class Sched, bool ALIGN_EPI = false, bool SP2 = false>
__device__ __forceinline__ void gemm_phase(PG8_LAS unsigned char* lds, const Gemm g, const Sched& S, const Epi& E, const int wave_in) {
    unsigned ones_ = ~0u; asm volatile("" : "+s"(ones_)); int tid_ = wave_in * 64 + (int)__builtin_amdgcn_mbcnt_hi(ones_, __builtin_amdgcn_mbcnt_lo(ones_, 0u)); asm volatile("" : "+v"(tid_));
    const int tid = tid_, wid = wave_in, lane = tid & 63, wr = wid >> 2, wc = wid & 3, fr = lane & 15, fq = lane >> 4;
    const int K = g.K, nt = K / BK;
    unsigned voffA[2], voffB[2];
#pragma unroll
    for (int i = 0; i < 2; ++i) { int R, C; stage_rc(tid * 16 + i * 8192, R, C); const int Rb = Epi::PERM ? ((R & ~31) + perm32(R & 31)) : R;
        const int Ra = Epi::AROWPERM ? 128 * ((R >> 6) & 1) + 8 * (R & 15) + ((R >> 4) & 3) : R;
        voffA[i] = (unsigned)(Ra * K + C) * 2u; voffB[i] = (unsigned)(Rb * K + C) * 2u; }
    const size_t kstep = (size_t)(BK * 2);
    const size_t hstep = (size_t)HALF * K * 2;
    const size_t hstepB = hstep, hstepA = Epi::AROWPERM ? (size_t)4 * K * 2 : hstep;
    const size_t tstep = 2 * hstep;
    const unsigned ldsw = (unsigned)wid * 1024u;
    const int aoff = lds_byte(wr * 64 + fr, fq * 8), boff = lds_byte(wc * 32 + fr, fq * 8);
#define PG8_SA(b, h) (((b) * 2 + (h)) * HTB)
#define PG8_SB(b, h) ((4 + (b) * 2 + (h)) * HTB)
#define PG8_STAGE(bufoff, gbase, voff) do { _Pragma("unroll") for (int _i = 0; _i < 2; ++_i) \
        __builtin_amdgcn_global_load_lds((const unsigned*)((const char*)(gbase) + (voff)[_i]), (PG8_LAS unsigned*)(lds + (bufoff) + ldsw + _i * 8192), 16, 0, 0); } while (0)
#define PG8_LDA(dst, b, h) do { _Pragma("unroll") for (int m = 0; m < 4; ++m) _Pragma("unroll") for (int k = 0; k < 2; ++k) dst[m][k] = *(const PG8_LAS bf16x8*)(lds + PG8_SA(b, h) + aoff + m * 2048 + k * 1024); } while (0)
#define PG8_LDB(dst, b, h) do { _Pragma("unroll") for (int n = 0; n < 2; ++n) _Pragma("unroll") for (int k = 0; k < 2; ++k) dst[n][k] = *(const PG8_LAS bf16x8*)(lds + PG8_SB(b, h) + boff + n * 2048 + k * 1024); } while (0)
#define PG8_MMA(ai, bj, At, Bt) do { __builtin_amdgcn_s_setprio(1); _Pragma("unroll") for (int m = 0; m < 4; ++m) _Pragma("unroll") for (int n = 0; n < 2; ++n) _Pragma("unroll") for (int k = 0; k < 2; ++k) \
        acc[ai][bj][m][n] = __builtin_amdgcn_mfma_f32_16x16x32_bf16(Bt[n][k], At[m][k], acc[ai][bj][m][n], 0, 0, 0); __builtin_amdgcn_s_setprio(0); } while (0)
#define PG8_WAIT_V(n) asm volatile("s_waitcnt vmcnt(" #n ")" ::: "memory")
#define PG8_WAIT_L(n) asm volatile("s_waitcnt lgkmcnt(" #n ")" ::: "memory")
#define PG8_BAR __builtin_amdgcn_s_barrier()
#define PG8_SCHED __builtin_amdgcn_sched_barrier(0)
    Unit cur, nxt; int ui = 0;
    if (!S.next(0, cur)) return;
    f32x4 acc[2][2][4][2];
#pragma unroll
    for (int a = 0; a < 2; ++a)
#pragma unroll
        for (int b = 0; b < 2; ++b)
#pragma unroll
            for (int m = 0; m < 4; ++m)
#pragma unroll
                for (int n = 0; n < 2; ++n) acc[a][b][m][n] = (f32x4){0.f, 0.f, 0.f, 0.f};
    bf16x8 At[4][2], B0[2][2], B1[2][2];
    const char* cA = (const char*)(g.A + cur.seg * g.a_seg) + (size_t)cur.pm * tstep; const char* cB = (const char*)(g.Bt + cur.seg * g.b_seg) + (size_t)cur.pn * tstep;
    S.a_ready(cur);
    if constexpr (SP2) {
        PG8_STAGE(PG8_SB(0, 0), cB, voffB); PG8_STAGE(PG8_SB(0, 1), cB + hstepB, voffB); PG8_STAGE(PG8_SA(0, 0), cA, voffA); PG8_STAGE(PG8_SA(0, 1), cA + hstepA, voffA);
        if (wr == 1) PG8_BAR;
        PG8_WAIT_V(2); PG8_BAR;
        PG8_STAGE(PG8_SB(1, 0), cB + kstep, voffB); PG8_STAGE(PG8_SA(1, 0), cA + kstep, voffA); PG8_STAGE(PG8_SB(1, 1), cB + hstepB + kstep, voffB);
        PG8_WAIT_V(6); PG8_BAR;
    } else {
        PG8_STAGE(PG8_SB(0, 0), cB, voffB); PG8_STAGE(PG8_SA(0, 0), cA, voffA); PG8_STAGE(PG8_SB(0, 1), cB + hstepB, voffB); PG8_STAGE(PG8_SA(0, 1), cA + hstepA, voffA);
        if (wr == 1) PG8_BAR;
        PG8_WAIT_V(4); PG8_BAR;
        PG8_STAGE(PG8_SB(1, 0), cB + kstep, voffB); PG8_STAGE(PG8_SA(1, 0), cA + kstep, voffA); PG8_STAGE(PG8_SB(1, 1), cB + hstepB + kstep, voffB);
        PG8_WAIT_V(6); PG8_BAR;
    }
    for (;;) {
        const bool has_next = S.next(ui + 1, nxt);
        const char* nA = has_next ? (const char*)(g.A + nxt.seg * g.a_seg) + (size_t)nxt.pm * tstep : cA; const char* nB = has_next ? (const char*)(g.Bt + nxt.seg * g.b_seg) + (size_t)nxt.pn * tstep : cB;
        for (int t = 0; t < nt; t += 2) {
            const bool last = (t == nt - 2);
            const char* a1 = cA + (size_t)(t + 1) * kstep;
            const char* a2 = last ? nA : cA + (size_t)(t + 2) * kstep; const char* b2 = last ? nB : cB + (size_t)(t + 2) * kstep;
            const char* a3 = a2 + kstep; const char* b3 = b2 + kstep;
            if (last && has_next) S.a_ready(nxt);
            if constexpr (SP2) {
            PG8_LDB(B0, 0, 0); PG8_LDB(B1, 0, 1); PG8_SCHED; PG8_LDA(At, 0, 0); PG8_STAGE(PG8_SA(1, 1), a1 + hstepA, voffA);
            PG8_WAIT_V(8); PG8_WAIT_L(0); PG8_BAR; PG8_MMA(0, 0, At, B0); PG8_MMA(0, 1, At, B1); PG8_BAR; PG8_SCHED;
            PG8_LDA(At, 0, 1); PG8_STAGE(PG8_SB(0, 0), b2, voffB); PG8_STAGE(PG8_SB(0, 1), b2 + hstepB, voffB); PG8_STAGE(PG8_SA(0, 0), a2, voffA);
            PG8_WAIT_V(8); PG8_WAIT_L(0); PG8_BAR; PG8_MMA(1, 0, At, B0); PG8_MMA(1, 1, At, B1); PG8_BAR; PG8_SCHED;
            PG8_LDB(B0, 1, 0); PG8_LDB(B1, 1, 1); PG8_SCHED; PG8_LDA(At, 1, 0); PG8_STAGE(PG8_SA(0, 1), a2 + hstepA, voffA);
            PG8_WAIT_V(8); PG8_WAIT_L(0); PG8_BAR; PG8_MMA(0, 0, At, B0); PG8_MMA(0, 1, At, B1); PG8_BAR; PG8_SCHED;
            PG8_LDA(At, 1, 1); PG8_STAGE(PG8_SB(1, 0), b3, voffB); PG8_STAGE(PG8_SB(1, 1), b3 + hstepB, voffB); PG8_STAGE(PG8_SA(1, 0), a3, voffA);
            PG8_WAIT_V(8); PG8_WAIT_L(0); PG8_BAR; PG8_MMA(1, 0, At, B0); PG8_MMA(1, 1, At, B1); PG8_BAR; PG8_SCHED;
            } else {
            PG8_LDB(B0, 0, 0); PG8_SCHED; PG8_LDA(At, 0, 0); PG8_STAGE(PG8_SA(1, 1), a1 + hstepA, voffA);
            PG8_WAIT_L(8); PG8_BAR; PG8_WAIT_L(0); PG8_MMA(0, 0, At, B0); PG8_BAR; PG8_SCHED;
            PG8_LDB(B1, 0, 1); PG8_STAGE(PG8_SB(0, 0), b2, voffB);
            PG8_BAR; PG8_WAIT_L(0); PG8_MMA(0, 1, At, B1); PG8_BAR;
            PG8_LDA(At, 0, 1); PG8_STAGE(PG8_SA(0, 0), a2, voffA);
            PG8_BAR; PG8_WAIT_L(0); PG8_MMA(1, 0, At, B0); PG8_BAR; PG8_SCHED;
            PG8_STAGE(PG8_SB(0, 1), b2 + hstepB, voffB);
            PG8_WAIT_V(6); PG8_BAR; PG8_MMA(1, 1, At, B1); PG8_BAR;
            PG8_LDB(B0, 1, 0); PG8_SCHED; PG8_LDA(At, 1, 0); PG8_STAGE(PG8_SA(0, 1), a2 + hstepA, voffA);
            PG8_WAIT_L(8); PG8_BAR; PG8_WAIT_L(0); PG8_MMA(0, 0, At, B0); PG8_BAR; PG8_SCHED;
            PG8_LDB(B1, 1, 1); PG8_STAGE(PG8_SB(1, 0), b3, voffB);
            PG8_BAR; PG8_WAIT_L(0); PG8_MMA(0, 1, At, B1); PG8_BAR;
            PG8_LDA(At, 1, 1); PG8_STAGE(PG8_SA(1, 0), a3, voffA);
            PG8_BAR; PG8_WAIT_L(0); PG8_MMA(1, 0, At, B0); PG8_BAR; PG8_SCHED;
            PG8_STAGE(PG8_SB(1, 1), b3 + hstepB, voffB);
            PG8_WAIT_V(6); PG8_BAR; PG8_MMA(1, 1, At, B1); PG8_BAR;
            }
        }
        if constexpr (ALIGN_EPI) { if (wr == 0) PG8_BAR; }
        if constexpr (!Epi::AFTER_DRAIN) { E(acc, cur, wr, wc, fr, fq); S.done(cur); }
        if (!has_next) break;
        if (!Epi::MULTISEG || nxt.seg == 0)
#pragma unroll
        for (int a = 0; a < 2; ++a)
#pragma unroll
            for (int b = 0; b < 2; ++b)
#pragma unroll
                for (int m = 0; m < 4; ++m)
#pragma unroll
                    for (int n = 0; n < 2; ++n) acc[a][b][m][n] = (f32x4){0.f, 0.f, 0.f, 0.f};
        cur = nxt; cA = nA; cB = nB; ++ui;
        if constexpr (ALIGN_EPI) { if (wr == 1) PG8_BAR; }
    }
    PG8_WAIT_V(0);
    if constexpr (!ALIGN_EPI) { if (wr == 0) PG8_BAR; }
    PG8_BAR;
    if constexpr (Epi::AFTER_DRAIN) { E.fused(acc, cur, wr, wc, fr, fq, lds, wid, lane); S.done(cur); }
#undef PG8_SA
#undef PG8_SB
#undef PG8_STAGE
#undef PG8_LDA
#undef PG8_LDB
#undef PG8_MMA
#undef PG8_WAIT_V
#undef PG8_WAIT_L
#undef PG8_BAR
#undef PG8_SCHED
}
}

#define GAS __attribute__((address_space(1)))
#define LAS __attribute__((address_space(3)))
#define DI __device__ __forceinline__
typedef unsigned short bf16;
typedef unsigned v2u __attribute__((ext_vector_type(2)));
typedef unsigned v4u __attribute__((ext_vector_type(4)));
typedef float f32x2 __attribute__((ext_vector_type(2)));
typedef float f32x4 __attribute__((ext_vector_type(4)));
typedef float f32x16 __attribute__((ext_vector_type(16)));
typedef short bf16x8 __attribute__((ext_vector_type(8)));
typedef short s16x4 __attribute__((ext_vector_type(4)));
typedef __bf16 hbf2 __attribute__((ext_vector_type(2)));

constexpr int NWAVES = 8;
#ifndef GALIGN
#define GALIGN true
#endif
#ifndef GSP2
#define GSP2 true
#endif
#ifndef MK_ONE_LAUNCH
#define MK_ONE_LAUNCH 1
#endif

constexpr int D = 2048, TP = 8192, TS = 512, MROWS = TP + TS, NPROJ = 15360, NIN = 15376, DFF = 5632, NUP = 11264, NBATCH = 132, NMOD = 12288;
constexpr int SEQ = 2048, PAST = 16384;
constexpr int MG_COL = 9216;
constexpr float EPS = 1e-6f, LOG2E = 1.4426950408889634f, KSCALE = 0.08838834764831845f;
constexpr size_t O_YP = 0, O_YS = 16777216, O_PST = 17825792  , O_PCONV = 20971520, O_SST = 21151744  , O_SCONV = 121815040;
constexpr size_t MiB = 1u << 20;
constexpr size_t WS_CTL = 0, CTL_BYTES = 64 * 1024;
constexpr size_t WS_WIN = 1 * MiB, WS_WBR = 121 * MiB, WS_WOUT = 145 * MiB, WS_WUP = 161 * MiB, WS_WDN = 249 * MiB, WS_MOD = 293 * MiB, WS_AC = 306 * MiB, WS_ROPE = 307 * MiB;
constexpr size_t WS_WG = 128 * 1024;
constexpr size_t WS_XA = 309 * MiB, WS_H = 377 * MiB, WS_PROJ = 411 * MiB, WS_U = WS_PROJ, WS_LOGA = 666 * MiB, WS_ON = 683 * MiB, WS_MF = 734 * MiB, WS_MB = 802 * MiB, WS_ACT = 836 * MiB, WS_DS = 930 * MiB, WS_DT = 949 * MiB, WS_LOGH = 950 * MiB, WS_UH = 967 * MiB, WS_END = 979 * MiB;
constexpr size_t MOD_BYTES = (size_t)2 * NBATCH * NMOD * 4;
constexpr int CW_TMO = 0, CW_QUEUE = 64  , CW_BAR = 4096;
constexpr int LDS_BYTES = 155648;
constexpr int LDS_MISC = 155648 - 256;

DI unsigned pk2(float lo, float hi) { f32x2 v = {lo, hi}; hbf2 r = __builtin_convertvector(v, hbf2); return __builtin_bit_cast(unsigned, r); }
DI float bflo(unsigned u) { return __uint_as_float(u << 16); }
DI float bfhi(unsigned u) { return __uint_as_float(u & 0xffff0000u); }
DI float ex2(float x) { return __builtin_amdgcn_exp2f(x); }
DI float rcp(float x) { return __builtin_amdgcn_rcpf(x); }
DI float sigm(float x) { return rcp(1.0f + ex2(-LOG2E * x)); }
DI float silu(float x) { return x * sigm(x); }
DI float wave_sum(float v) {
#pragma unroll
    for (int o = 1; o < 64; o <<= 1) v += __shfl_xor(v, o);
    return v;
}
typedef const GAS char* gcp_t;
DI gcp_t uni(const void* p) { const unsigned long long v = (unsigned long long)p; const unsigned lo = __builtin_amdgcn_readfirstlane((unsigned)v), hi = __builtin_amdgcn_readfirstlane((unsigned)(v >> 32));
    return (gcp_t)(((unsigned long long)hi << 32) | lo); }
#define LDS_WAIT() asm volatile("s_waitcnt lgkmcnt(0)" ::: "memory")
#define VM_WAIT() asm volatile("s_waitcnt vmcnt(0)" ::: "memory")

#define XB_TMO      128
#define XB_XCNT(j)  (256  + 64 * (j))
#define XB_XSUB(j)  (1280 + 64 * (j))
#define XB_XGEN(j)  (2304 + 64 * (j))
#define XB_TOP      3328
#define XB_TOPGEN   3392
#define XCD_BAR_WORDS 3456
#define XB_SPIN_CAP (1u << 18)

__device__ __forceinline__ unsigned xb_ld(unsigned* p)              { return __hip_atomic_load(p, __ATOMIC_RELAXED, __HIP_MEMORY_SCOPE_AGENT); }
__device__ __forceinline__ unsigned xb_add(unsigned* p, unsigned v) { return __hip_atomic_fetch_add(p, v, __ATOMIC_RELAXED, __HIP_MEMORY_SCOPE_AGENT); }
__device__ __forceinline__ unsigned xb_xcc_id() { return (unsigned)__builtin_amdgcn_s_getreg((3 << 11) | 20) & 0xFu; }
#define XB_SPIN(cond, bar) do { unsigned _sp = 0; while (cond) { __builtin_amdgcn_s_sleep(1); \
    if ((++_sp & 255u) == 0u) { if (xb_ld(&(bar)[XB_TMO])) break; if (_sp > XB_SPIN_CAP) { atomicAdd(&(bar)[XB_TMO], 1u); break; } } } } while (0)

struct XcdBarrier {
    unsigned* bar; unsigned x; int wv;
    volatile LAS unsigned* st;
};

__device__ __forceinline__ XcdBarrier xcd_barrier_post(unsigned* bar, volatile LAS unsigned* st) {
    XcdBarrier b; b.bar = bar; b.x = xb_xcc_id(); b.st = st;
    if (threadIdx.x == 0) (void)xb_add(&bar[XB_XCNT(b.x)], 1u);
    return b;
}
__device__ __forceinline__ void xcd_barrier_complete(unsigned* bar, unsigned x, unsigned& nloc, unsigned& nx) {
    const unsigned G = gridDim.x * gridDim.y * gridDim.z;
    unsigned sum, cnt, mine, sp = 0u;
    for (;;) {
        sum = 0u; cnt = 0u; mine = 0u;
#pragma unroll
        for (unsigned j = 0; j < 16; ++j) { const unsigned c = xb_ld(&bar[XB_XCNT(j)]); sum += c; cnt += (c > 0u) ? 1u : 0u; mine = (j == x) ? c : mine; }
        if (sum == G) break;
        __builtin_amdgcn_s_sleep(1);
        if ((++sp & 255u) == 0u) { if (xb_ld(&bar[XB_TMO])) break; if (sp > XB_SPIN_CAP) { atomicAdd(&bar[XB_TMO], 1u); break; } }
    }
    nloc = mine > 0u ? mine : 1u; nx = cnt > 0u ? cnt : 1u;
}

__device__ __forceinline__ void xcd_barrier(const XcdBarrier& b_in) {
    XcdBarrier b = b_in; asm volatile("" : "+s"(b.bar)); b.bar = (unsigned*)(__attribute__((address_space(1))) unsigned*)b.bar;
    asm volatile("s_waitcnt vmcnt(0)" ::: "memory");
    __syncthreads();
    unsigned ones_ = ~0u; asm volatile("" : "+s"(ones_));
    if (b.wv == 0 && __builtin_amdgcn_mbcnt_hi(ones_, __builtin_amdgcn_mbcnt_lo(ones_, 0u)) == 0u) {
        unsigned* bar = b.bar;
        __builtin_amdgcn_s_waitcnt(0);
        unsigned nloc = b.st[0], nx = b.st[1];
        if (nloc == 0u) { xcd_barrier_complete(bar, b.x, nloc, nx); b.st[0] = nloc; b.st[1] = nx; }
        const unsigned old = xb_add(&bar[XB_XSUB(b.x)], 1u);
        const unsigned gen = old / nloc;
        if (old + 1u == (gen + 1u) * nloc) {
            __builtin_amdgcn_fence(__ATOMIC_RELEASE, "agent");
            asm volatile("s_waitcnt vmcnt(0)" ::: "memory");
            const unsigned og = xb_add(&bar[XB_TOP], 1u);
            const unsigned tg = og / nx;
            if (og + 1u == (tg + 1u) * nx) xb_add(&bar[XB_TOPGEN], 1u);
            else XB_SPIN(xb_ld(&bar[XB_TOPGEN]) == tg, bar);
            __builtin_amdgcn_fence(__ATOMIC_ACQUIRE, "agent");
            xb_add(&bar[XB_XGEN(b.x)], 1u);
            asm volatile("s_waitcnt vmcnt(0)" ::: "memory");
        } else {
            XB_SPIN(xb_ld(&bar[XB_XGEN(b.x)]) == gen, bar);
            __builtin_amdgcn_fence(__ATOMIC_ACQUIRE, "agent");
            asm volatile("s_waitcnt vmcnt(0)" ::: "memory");
        }
    }
    __syncthreads();
}
DI int rope_pos(int c) { return c < 64 ? 8 * (c >> 2) + (c & 3) : 8 * ((c - 64) >> 2) + 4 + ((c - 64) & 3); }
DI int rope_chan(int p) { const int e = p & 7, a = p >> 3; return e < 4 ? 4 * a + e : 64 + 4 * a + (e - 4); }
template <bool ROPEPERM = false, bool UPPERM = false>
DI void transpose_item(const float* W, int ldw, int col0, bf16* WT, int K, int dst_row0, LAS float* scr, int kb, int nb, int lane) {
    const int k0 = 64 * kb, n0 = 32 * nb;
#pragma unroll 8
    for (int i = 0; i < 32; ++i) { const int kk = 2 * i + (lane >> 5); scr[kk * 33 + (lane & 31)] = __builtin_nontemporal_load(W + (size_t)(k0 + kk) * ldw + col0 + n0 + (lane & 31)); }
    LDS_WAIT(); asm volatile("" ::: "memory");
    const int c = lane & 7;
#pragma unroll
    for (int j = 0; j < 4; ++j) { const int n = (lane >> 3) + 8 * j; const LAS float* s = scr + (8 * c) * 33 + n;
        v4u o; o.x = pk2(s[0 * 33], s[1 * 33]); o.y = pk2(s[2 * 33], s[3 * 33]); o.z = pk2(s[4 * 33], s[5 * 33]); o.w = pk2(s[6 * 33], s[7 * 33]);
        int drow = dst_row0 + n0 + n; if (ROPEPERM && (n0 + n) < 1024) drow = dst_row0 + ((n0 + n) & ~127) + rope_pos((n0 + n) & 127);
        if (UPPERM) { const int nn = n0 + n, hb = nn >= DFF ? 1 : 0, x = nn - hb * DFF; drow = dst_row0 + 256 * (x >> 7) + 128 * hb + (x & 127); }
        *(v4u*)(WT + (size_t)drow * K + k0 + 8 * c) = o; }
    LDS_WAIT(); asm volatile("" ::: "memory");
}
DI void p0_prologue(LAS unsigned char* lds, int gw, int NGW, int wave, int lane, const float* w_in, const float* w_br, const float* w_out, const float* w_up, const float* w_dn, const float* cp, const float* cs, unsigned char* ws) {
    LAS float* scr = (LAS float*)(lds + wave * 16384);
    bf16* WIN = (bf16*)(ws + WS_WIN); bf16* WBR = (bf16*)(ws + WS_WBR); bf16* WOUT = (bf16*)(ws + WS_WOUT); bf16* WUP = (bf16*)(ws + WS_WUP); bf16* WDN = (bf16*)(ws + WS_WDN);
    constexpr int I_A = 32 * 192, I_B = 32 * 288, I_C = 3 * 16 * 64, I_D = 32 * 64, I_E = 32 * 352, I_F = 88 * 64, I_L = I_A + I_B + I_C + I_D + I_E + I_F;
    for (int it = gw; it < 2 * I_L; it += NGW) {
        const int l = it / I_L; int r = it % I_L;
        if (r < I_A) { transpose_item<true>(w_in + (size_t)l * D * NIN, NIN, 0, WIN + (size_t)l * NPROJ * D, D, 0, scr, r / 192, r % 192, lane); continue; } r -= I_A;
        if (r < I_B) { transpose_item(w_in + (size_t)l * D * NIN, NIN, 6160, WIN + (size_t)l * NPROJ * D, D, 6144, scr, r / 288, r % 288, lane); continue; } r -= I_B;
        if (r < I_C) { const int br = r / 1024, rr = r % 1024; transpose_item(w_br + (size_t)(l * 3 + br) * 1024 * D, D, 0, WBR + (size_t)(l * 3 + br) * D * 1024, 1024, 0, scr, rr / 64, rr % 64, lane); continue; } r -= I_C;
        if (r < I_D) { transpose_item(w_out + (size_t)l * D * D, D, 0, WOUT + (size_t)l * D * D, D, 0, scr, r / 64, r % 64, lane); continue; } r -= I_D;
        if (r < I_E) { transpose_item<false, true>(w_up + (size_t)l * D * NUP, NUP, 0, WUP + (size_t)l * NUP * D, D, 0, scr, r / 352, r % 352, lane); continue; } r -= I_E;
        transpose_item(w_dn + (size_t)l * DFF * D, D, 0, WDN + (size_t)l * D * DFF, DFF, 0, scr, r / 64, r % 64, lane);
    }
    { v4u* mz = (v4u*)(ws + WS_MOD); for (size_t i = (size_t)gw * 64 + lane; i < MOD_BYTES / 16; i += (size_t)NGW * 64) mz[i] = (v4u){0u, 0u, 0u, 0u}; }
    { bf16* WG = (bf16*)(ws + WS_WG);
      for (int idx = gw * 64 + lane; idx < 2 * 16 * D; idx += NGW * 64) { const int l = idx >> 15, j = (idx >> 11) & 15, k = idx & 2047;
          const float v = w_in[(size_t)l * D * NIN + (size_t)k * NIN + 6144 + j]; const unsigned hi = pk2(v, 0.f) & 0xffffu; const float vh = bflo(hi);
          WG[(size_t)(l * 2 + 0) * 16 * D + j * D + k] = (bf16)hi; WG[(size_t)(l * 2 + 1) * 16 * D + j * D + k] = (bf16)(pk2(v - vh, 0.f) & 0xffffu); } }
    unsigned* AC = (unsigned*)(ws + WS_AC);
    for (int idx = gw * 64 + lane; idx < 160 * 1024; idx += NGW * 64) { const int row = idx >> 10, c2 = (idx & 1023) * 2;
        float a = 0.f, b = 0.f;
        if (row < 4) { a = cp[row * D + c2]; b = cp[row * D + c2 + 1]; } else if (row < NBATCH) { a = cs[(row - 4) * D + c2]; b = cs[(row - 4) * D + c2 + 1]; }
        AC[idx] = pk2(silu(a), silu(b)); }
    float* RT = (float*)(ws + WS_ROPE);
    for (int idx = gw * 64 + lane; idx < 2052 * 64; idx += NGW * 64) { const int p = idx >> 6, j = idx & 63; const int pos = p < SEQ ? p : PAST + (p - SEQ);
        const float inv = (float)exp2(-(double)j * (13.287712379549449 / 64.0));
        const float ang = (float)pos * inv;
        double rev = (double)ang * 0.15915494309189535; rev -= rint(rev);
        const float rv = (float)rev;
        RT[p * 128 + j] = __builtin_amdgcn_cosf(rv); RT[p * 128 + 64 + j] = __builtin_amdgcn_sinf(rv); }
}
DI void p1_mod(int gw, int NGW, int lane, const float* w_ada, const float* b_ada, unsigned char* ws, size_t mod_off) {
    const bf16* AC = (const bf16*)(ws + WS_AC); float* MOD = (float*)(ws + mod_off);
    const int r = lane & 31, h = lane >> 5;
    const int wv_ = gw & 7, cu_ = gw >> 3, ncu_ = NGW >> 3;
    if (wv_ >= 6) return;
    for (int task = cu_ * 6 + wv_; task < 1536; task += ncu_ * 6) {
        const int kh = task & 1, ct = (task >> 1) % 384, l = task / 768, n0 = 32 * ct, kbase = 1024 * kh;
        const float* W = w_ada + (size_t)l * D * NMOD + n0 + r;
        f32x16 acc[5];
#pragma unroll
        for (int i = 0; i < 5; ++i)
#pragma unroll
            for (int q = 0; q < 16; ++q) acc[i][q] = 0.f;
#pragma unroll 1
        for (int kg4 = 0; kg4 < 16; ++kg4) {
            f32x4 bw[4][2]; bf16x8 af[4][5];
#pragma unroll
            for (int s4 = 0; s4 < 4; ++s4) { const int k0 = kbase + 16 * (4 * kg4 + s4) + 8 * h;
#pragma unroll
                for (int j = 0; j < 8; ++j) bw[s4][j >> 2][j & 3] = __builtin_nontemporal_load(W + (size_t)(k0 + j) * NMOD);
#pragma unroll
                for (int i = 0; i < 5; ++i) af[s4][i] = *(const bf16x8*)(AC + (size_t)(32 * i + r) * D + k0); }
            asm volatile("" : "+v"(bw[0][0]), "+v"(bw[0][1]), "+v"(bw[1][0]), "+v"(bw[1][1]), "+v"(bw[2][0]), "+v"(bw[2][1]), "+v"(bw[3][0]), "+v"(bw[3][1]),
                              "+v"(af[0][0]), "+v"(af[0][1]), "+v"(af[0][2]), "+v"(af[0][3]), "+v"(af[0][4]), "+v"(af[1][0]), "+v"(af[1][1]), "+v"(af[1][2]), "+v"(af[1][3]), "+v"(af[1][4]),
                              "+v"(af[2][0]), "+v"(af[2][1]), "+v"(af[2][2]), "+v"(af[2][3]), "+v"(af[2][4]), "+v"(af[3][0]), "+v"(af[3][1]), "+v"(af[3][2]), "+v"(af[3][3]), "+v"(af[3][4]));
#pragma unroll
            for (int s4 = 0; s4 < 4; ++s4) {
                v4u bp; bp.x = pk2(bw[s4][0][0], bw[s4][0][1]); bp.y = pk2(bw[s4][0][2], bw[s4][0][3]); bp.z = pk2(bw[s4][1][0], bw[s4][1][1]); bp.w = pk2(bw[s4][1][2], bw[s4][1][3]);
                const bf16x8 bfrag = __builtin_bit_cast(bf16x8, bp);
#pragma unroll
                for (int i = 0; i < 5; ++i) acc[i] = __builtin_amdgcn_mfma_f32_32x32x16_bf16(af[s4][i], bfrag, acc[i], 0, 0, 0); } }
        const float bias = kh == 0 ? b_ada[l * NMOD + n0 + r] : 0.f;
#pragma unroll
        for (int i = 0; i < 5; ++i)
#pragma unroll
            for (int q = 0; q < 16; ++q) { const int bi = 32 * i + (q & 3) + 8 * (q >> 2) + 4 * h;
                if (bi < NBATCH) atomicAdd(MOD + ((size_t)(l * NBATCH + bi)) * NMOD + n0 + r, acc[i][q] + bias); }
    }
}
DI void xrow_load(f32x4 (&d)[8], int use_in, int row, int lane, const float* xp, const float* xs, const bf16* XA) {
    if (use_in) { const float* xr = row < TP ? xp + (size_t)row * D : xs + (size_t)(row - TP) * D;
#pragma unroll
        for (int j = 0; j < 8; ++j) d[j] = *(const f32x4*)(xr + 4 * lane + 256 * j);
    } else { const bf16* xr = XA + (size_t)row * D;
#pragma unroll
        for (int j = 0; j < 8; ++j) { const v2u t = *(const v2u*)(xr + 4 * lane + 256 * j); d[j] = (f32x4){bflo(t.x), bfhi(t.x), bflo(t.y), bfhi(t.y)}; } }
}
DI int bidx_of(int row) { return row < TP ? (row >> 11) : 4 + ((row - TP) >> 2); }
template <bool GLR>
DI void norm_phase(LAS unsigned char* lds, int gw, int NGW, int tid, int lane, int l, int use_in  , const float* xp, const float* xs, const bf16* XA,
                   const float* nw  , const float* mod  , int sh_idx, int sc_idx, bf16* H,
                   const float* w_in_l  , const float* wlr  , const float* blr  , float* LOGA) {
    LAS float* wT = (LAS float*)lds;
    if (GLR) {
        for (int e = tid; e < 16 * D; e += NWAVES * 64) { const int k = e >> 4, j = e & 15; wT[j * D + k] = w_in_l[(size_t)k * NIN + 6144 + j]; }
        __syncthreads();
    }
    const int npr = 4 * (4 * gw < TP ? (TP - 4 * gw + 4 * NGW - 1) / (4 * NGW) : 0), nsr = gw < TS ? (TS - gw + NGW - 1) / NGW : 0;
#define NORM_ROW(it_) ((it_) < npr ? 4 * gw + ((it_) >> 2) * 4 * NGW + ((it_) & 3) : TP + gw + ((it_) - npr) * NGW)
    f32x4 nx[8];
    if (!GLR && npr + nsr > 0) xrow_load(nx, use_in, NORM_ROW(0), lane, xp, xs, XA);
    int cur_b = -1; f32x4 gsc[8], gsh[8];
    for (int it = 0; it < npr + nsr; ++it) {
        const int row = NORM_ROW(it);
        const int bi = bidx_of(row);
        const float* mr = mod + (size_t)bi * NMOD;
        if (!GLR && bi != cur_b) { cur_b = bi;
            f32x4 tw[8], tsc[8];
#pragma unroll
            for (int j = 0; j < 8; ++j) { const int c = 4 * lane + 256 * j; tw[j] = *(const f32x4*)(nw + c); tsc[j] = *(const f32x4*)(mr + sc_idx * D + c); gsh[j] = *(const f32x4*)(mr + sh_idx * D + c); }
            asm volatile("" : "+v"(tw[0]), "+v"(tw[1]), "+v"(tw[2]), "+v"(tw[3]), "+v"(tw[4]), "+v"(tw[5]), "+v"(tw[6]), "+v"(tw[7]),
                              "+v"(tsc[0]), "+v"(tsc[1]), "+v"(tsc[2]), "+v"(tsc[3]), "+v"(tsc[4]), "+v"(tsc[5]), "+v"(tsc[6]), "+v"(tsc[7]),
                              "+v"(gsh[0]), "+v"(gsh[1]), "+v"(gsh[2]), "+v"(gsh[3]), "+v"(gsh[4]), "+v"(gsh[5]), "+v"(gsh[6]), "+v"(gsh[7]));
#pragma unroll
            for (int j = 0; j < 8; ++j) gsc[j] = tw[j] * (1.0f + tsc[j]); }
        f32x4 v[8]; float ss = 0.f;
#pragma unroll
        for (int j = 0; j < 8; ++j) { if (!GLR) v[j] = nx[j]; }
        if (GLR) xrow_load(v, use_in, row, lane, xp, xs, XA);
#pragma unroll
        for (int j = 0; j < 8; ++j) ss += (v[j].x * v[j].x + v[j].y * v[j].y) + (v[j].z * v[j].z + v[j].w * v[j].w);
        if (!GLR && it + 1 < npr + nsr) xrow_load(nx, use_in, NORM_ROW(it + 1), lane, xp, xs, XA);
        const float rstd = 1.0f / sqrtf(wave_sum(ss) * (1.0f / D) + EPS);
#pragma unroll
        for (int j = 0; j < 8; ++j) { const int c = 4 * lane + 256 * j;
            if (GLR) { const f32x4 w = *(const f32x4*)(nw + c), sc = *(const f32x4*)(mr + sc_idx * D + c), sh = *(const f32x4*)(mr + sh_idx * D + c); v[j] = (v[j] * rstd * w) * (1.0f + sc) + sh; }
            else v[j] = (v[j] * rstd) * gsc[j] + gsh[j];
            v2u o; o.x = pk2(v[j].x, v[j].y); o.y = pk2(v[j].z, v[j].w);
            *(v2u*)(H + (size_t)row * D + c) = o; }
        if (GLR) {
            float la[8];
            { const f32x4 a = *(const f32x4*)(blr + 8 * lane), b = *(const f32x4*)(blr + 8 * lane + 4);
              la[0] = a.x; la[1] = a.y; la[2] = a.z; la[3] = a.w; la[4] = b.x; la[5] = b.y; la[6] = b.z; la[7] = b.w; }
#pragma unroll
            for (int jj = 0; jj < 16; ++jj) { float s = 0.f;
                const f32x4 wa = *(const f32x4*)(wlr + jj * 512 + 8 * lane), wb = *(const f32x4*)(wlr + jj * 512 + 8 * lane + 4);
#pragma unroll
                for (int j = 0; j < 8; ++j) { const f32x4 w = *(const LAS f32x4*)(wT + jj * D + 4 * lane + 256 * j); s += (v[j].x * w.x + v[j].y * w.y) + (v[j].z * w.z + v[j].w * w.w); }
                const float gj = wave_sum(s);
                la[0] += gj * wa.x; la[1] += gj * wa.y; la[2] += gj * wa.z; la[3] += gj * wa.w; la[4] += gj * wb.x; la[5] += gj * wb.y; la[6] += gj * wb.z; la[7] += gj * wb.w;
                asm volatile("" ::: "memory"); }
#pragma unroll
            for (int i = 0; i < 8; ++i) { const float sv = la[i];
                const float t = ex2(-LOG2E * fabsf(sv));
                la[i] = (fminf(sv, 0.f) * LOG2E - __builtin_amdgcn_logf(1.0f + t)) * (1.0f / 16.0f); }
            float* lp = LOGA + (size_t)row * 512 + 8 * lane;
            *(f32x4*)lp = (f32x4){la[0], la[1], la[2], la[3]}; *(f32x4*)(lp + 4) = (f32x4){la[4], la[5], la[6], la[7]};
        }
    }
    if (GLR) __syncthreads();
}
DI void glr_phase(LAS unsigned char* lds, int vcu, int G, int tid, int w, int lane, const bf16* H, const bf16* WG, const float* wlr, const float* blr, float* LOGA) {
    constexpr int L_PG = 0, PGS = 20, PGW = 16 * PGS, L_GF = 8 * PGW * 4;
#define GLR_BAR() do { asm volatile("s_waitcnt lgkmcnt(0)" ::: "memory"); __builtin_amdgcn_s_barrier(); asm volatile("" ::: "memory"); } while (0)
    const int n16 = lane & 15, kg = lane >> 4, cq = lane & 15, rg = lane >> 4, col0 = 64 * w + 4 * cq;
    f32x4 wl[16];
#pragma unroll
    for (int jj = 0; jj < 16; ++jj) wl[jj] = *(const f32x4*)(wlr + jj * 512 + col0);
    const f32x4 bias = *(const f32x4*)(blr + col0);
    bf16x8 a[8], bh[8], bl[8];
#define GLR_LOAD(blk_) do { const bf16* hp_ = H + (size_t)(16 * (blk_) + n16) * D + 256 * w + 8 * kg; const bf16* wp_ = WG + (size_t)n16 * D + 256 * w + 8 * kg; \
        _Pragma("unroll") for (int s_ = 0; s_ < 8; ++s_) { a[s_] = *(const bf16x8*)(hp_ + 32 * s_); bh[s_] = *(const bf16x8*)(wp_ + 32 * s_); bl[s_] = *(const bf16x8*)(wp_ + 16 * D + 32 * s_); } } while (0)
    if (vcu < MROWS / 16) GLR_LOAD(vcu);
    __syncthreads();
    for (int blk = vcu; blk < MROWS / 16; blk += G) {
        const int row0 = 16 * blk;
        f32x4 acc = {0.f, 0.f, 0.f, 0.f};
#pragma unroll
        for (int s_ = 0; s_ < 8; ++s_) { acc = __builtin_amdgcn_mfma_f32_16x16x32_bf16(a[s_], bh[s_], acc, 0, 0, 0); acc = __builtin_amdgcn_mfma_f32_16x16x32_bf16(a[s_], bl[s_], acc, 0, 0, 0); }
#pragma unroll
        for (int i = 0; i < 4; ++i) *(LAS float*)(lds + L_PG + (w * PGW + (4 * kg + i) * PGS + n16) * 4) = acc[i];
        if (blk + G < MROWS / 16) GLR_LOAD(blk + G);
        GLR_BAR();
        if (tid < 256) { const int rr = tid >> 4, nn = tid & 15; float sg = 0.f;
#pragma unroll
            for (int ww = 0; ww < 8; ++ww) sg += *(const LAS float*)(lds + L_PG + (ww * PGW + rr * PGS + nn) * 4);
            *(LAS float*)(lds + L_GF + (rr * PGS + nn) * 4) = sg; }
        GLR_BAR();
#pragma unroll
        for (int i = 0; i < 4; ++i) { const int row = 4 * rg + i;
            const f32x4 ga = *(const LAS f32x4*)(lds + L_GF + (row * PGS) * 4), gb = *(const LAS f32x4*)(lds + L_GF + (row * PGS + 4) * 4),
                        gc = *(const LAS f32x4*)(lds + L_GF + (row * PGS + 8) * 4), gd = *(const LAS f32x4*)(lds + L_GF + (row * PGS + 12) * 4);
            f32x4 o = bias;
            o += ga.x * wl[0] + ga.y * wl[1] + ga.z * wl[2] + ga.w * wl[3];
            o += gb.x * wl[4] + gb.y * wl[5] + gb.z * wl[6] + gb.w * wl[7];
            o += gc.x * wl[8] + gc.y * wl[9] + gc.z * wl[10] + gc.w * wl[11];
            o += gd.x * wl[12] + gd.y * wl[13] + gd.z * wl[14] + gd.w * wl[15];
#pragma unroll
            for (int e = 0; e < 4; ++e) { const float sv = o[e]; const float t = ex2(-LOG2E * fabsf(sv));
                o[e] = (fminf(sv, 0.f) * LOG2E - __builtin_amdgcn_logf(1.0f + t)) * (1.0f / 16.0f); }
            *(f32x4*)(LOGA + (size_t)(row0 + row) * 512 + col0) = o; }
    }
    __syncthreads();
#undef GLR_LOAD
#undef GLR_BAR
}
DI void final_norm_phase(int gw, int NGW, int lane, const bf16* XA, const float* nw, float* out) {
    const int npr = 4 * (4 * gw < TP ? (TP - 4 * gw + 4 * NGW - 1) / (4 * NGW) : 0), nsr = gw < TS ? (TS - gw + NGW - 1) / NGW : 0;
    f32x4 wv[8];
#pragma unroll
    for (int j = 0; j < 8; ++j) wv[j] = *(const f32x4*)(nw + 4 * lane + 256 * j);
    f32x4 nx[8];
    if (npr + nsr > 0) xrow_load(nx, 0, NORM_ROW(0), lane, nullptr, nullptr, XA);
    for (int it = 0; it < npr + nsr; ++it) {
        const int row = NORM_ROW(it);
        float* orow = row < TP ? out + O_YP + (size_t)row * D : out + O_YS + (size_t)(row - TP) * D;
        f32x4 v[8]; float ss = 0.f;
#pragma unroll
        for (int j = 0; j < 8; ++j) { v[j] = nx[j]; ss += (v[j].x * v[j].x + v[j].y * v[j].y) + (v[j].z * v[j].z + v[j].w * v[j].w); }
        if (it + 1 < npr + nsr) xrow_load(nx, 0, NORM_ROW(it + 1), lane, nullptr, nullptr, XA);
        const float rstd = 1.0f / sqrtf(wave_sum(ss) * (1.0f / D) + EPS);
#pragma unroll
        for (int j = 0; j < 8; ++j) { const int c = 4 * lane + 256 * j; *(f32x4*)(orow + c) = v[j] * rstd * wv[j]; }
    }
}
#undef NORM_ROW
constexpr int NSEG = 4, CPS = 8, NSA = 256;
constexpr int R_QI = 0, R_QD = 17408, R_KD = 34816, R_KO = 52224, R_KU = 78336, R_V = 96768, R_P = 133632, R_WT = 142848, R_DEC = 146944, R_SS = 147456, R_END = 149504;
static_assert(R_END <= LDS_MISC, "rec LDS map");
#define MFMA32(a, b, c) __builtin_amdgcn_mfma_f32_32x32x16_bf16((a), (b), (c), 0, 0, 0)
#define MFMA16(a, b, c) __builtin_amdgcn_mfma_f32_16x16x32_bf16((a), (b), (c), 0, 0, 0)
#define BAR_LDS() do { asm volatile("s_waitcnt lgkmcnt(0)" ::: "memory"); __builtin_amdgcn_s_barrier(); asm volatile("" ::: "memory"); } while (0)

DI void rec_state(LAS unsigned char* lds, int tid, int w, int lane, int l, int idx, const bf16* proj, const float* loga, const float* logh, float* DS, float* DT) {
    const int seq = idx / (NSEG - 1), seg = idx - seq * (NSEG - 1);
    const int r = seq >> 4, b = (seq >> 2) & 3, hd = seq & 3;
    const int ch0 = 2 * lane, h = lane >> 5, r32 = lane & 31, V0 = 32 * w;
    const int kcol = 3072 * r + hd * 128 + ch0 + 512, vcolbase = 3072 * r + 1024 + hd * 256;
    const float* lg = r == 2 ? logh : loga;
    const float gret = __builtin_amdgcn_logf(1.0f - ex2(-5.0f - (float)hd));
    f32x16 S[4];
#pragma unroll
    for (int i = 0; i < 4; ++i)
#pragma unroll
        for (int q = 0; q < 16; ++q) S[i][q] = 0.f;
    float bt0s = 0.f, bt1s = 0.f;
    unsigned rk[8]; f32x2 rx[8];
    const int vrow = (tid >> 5) & 1, vc8 = (tid & 31) * 8;
    const unsigned koff = (unsigned)kcol * 2u, lgoff = (unsigned)ch0 * 4u, voff = ((unsigned)vrow * NPROJ + (unsigned)vc8) * 2u;
#define RS_LOAD(n_) do { const int ng_ = CPS * seg + (n_); const size_t row0_ = (size_t)b * SEQ + 64 * ng_; \
        _Pragma("unroll") for (int i = 0; i < 8; ++i) { rk[i] = *(const GAS unsigned*)(uni(proj + (row0_ + 8 * w + i) * NPROJ) + koff); \
            if (r != 0) rx[i] = *(const GAS f32x2*)(uni(lg + (row0_ + 8 * w + i) * 512 + hd * 128) + lgoff); } } while (0)
    RS_LOAD(0);
    v4u vr[4];
#define RS_VLOAD(n_) do { const size_t rowv_ = (size_t)b * SEQ + 64 * (CPS * seg + (n_)); \
        _Pragma("unroll") for (int i = 0; i < 4; ++i) vr[i] = *(const GAS v4u*)(uni(proj + (rowv_ + 16 * i + 2 * w) * NPROJ + vcolbase) + voff); } while (0)
    RS_VLOAD(0);
    for (int n = 0; n < CPS; ++n) {
        float c0[8], c1[8], k0[8], k1[8]; float cs0 = 0.f, cs1 = 0.f;
#pragma unroll
        for (int i = 0; i < 8; ++i) { k0[i] = bflo(rk[i]); k1[i] = bfhi(rk[i]);
            const float G0 = r == 0 ? gret : rx[i].x, G1 = r == 0 ? gret : rx[i].y;
            cs0 += G0; cs1 += G1; c0[i] = cs0; c1[i] = cs1; }
        RS_LOAD(n + 1 < CPS ? n + 1 : n);
        *(LAS f32x2*)(lds + R_WT + (w * 128 + ch0) * 4) = (f32x2){cs0, cs1};
        BAR_LDS();
        float st0 = 0.f, st1 = 0.f, T0 = 0.f, T1 = 0.f;
#pragma unroll
        for (int ww = 0; ww < 8; ++ww) { const f32x2 t = *(const LAS f32x2*)(lds + R_WT + (ww * 128 + ch0) * 4); if (ww == w) { st0 = T0; st1 = T1; } T0 += t.x; T1 += t.y; }
        unsigned ku0[4], ku1[4];
#pragma unroll
        for (int i = 0; i < 8; ++i) { const float u0 = k0[i] * ex2(T0 - (st0 + c0[i])), u1 = k1[i] * ex2(T1 - (st1 + c1[i]));
            if (i & 1) { ku0[i >> 1] |= pk2(0.f, u0); ku1[i >> 1] |= pk2(0.f, u1); } else { ku0[i >> 1] = pk2(u0, 0.f); ku1[i >> 1] = pk2(u1, 0.f); } }
        *(LAS v4u*)(lds + R_KU + ch0 * 144 + 16 * w) = (v4u){ku0[0], ku0[1], ku0[2], ku0[3]};
        *(LAS v4u*)(lds + R_KU + (ch0 + 1) * 144 + 16 * w) = (v4u){ku1[0], ku1[1], ku1[2], ku1[3]};
        if (w == 0) *(LAS f32x2*)(lds + R_DEC + ch0 * 4) = (f32x2){ex2(T0), ex2(T1)};
        bt0s += T0; bt1s += T1;
#pragma unroll
        for (int i = 0; i < 4; ++i) *(LAS v4u*)(lds + R_V + (2 * w + vrow + 16 * i) * 576 + vc8 * 2) = vr[i];
        RS_VLOAD(n + 1 < CPS ? n + 1 : n);
        BAR_LDS();
        bf16x8 vf[4];
        { const int g16 = (lane >> 4) & 1, q4 = (lane & 15) >> 2, p4 = lane & 3;
#pragma unroll
          for (int ks = 0; ks < 4; ++ks) { const int off = R_V + (16 * ks + 8 * h + q4) * 576 + (V0 + 16 * g16 + 4 * p4) * 2;
              const s16x4 lo = __builtin_amdgcn_ds_read_tr16_b64_v4i16((LAS s16x4*)(lds + off)), hi = __builtin_amdgcn_ds_read_tr16_b64_v4i16((LAS s16x4*)(lds + off + 4 * 576));
              vf[ks] = __builtin_shufflevector(lo, hi, 0, 1, 2, 3, 4, 5, 6, 7); } }
#pragma unroll
        for (int i = 0; i < 4; ++i) {
#pragma unroll
            for (int g = 0; g < 4; ++g) { const f32x4 dc = *(const LAS f32x4*)(lds + R_DEC + (32 * i + 8 * g + 4 * h) * 4);
                S[i][4 * g] *= dc.x; S[i][4 * g + 1] *= dc.y; S[i][4 * g + 2] *= dc.z; S[i][4 * g + 3] *= dc.w; }
#pragma unroll
            for (int ks = 0; ks < 4; ++ks) { const bf16x8 kf = *(const LAS bf16x8*)(lds + R_KU + (32 * i + r32) * 144 + (16 * ks + 8 * h) * 2);
                S[i] = MFMA32(kf, vf[ks], S[i]); }
            asm volatile("" ::: "memory");
        }
    }
#undef RS_LOAD
    float* so = DS + (size_t)idx * 32768 + V0;
    const unsigned soff = ((unsigned)(4 * h) * 256u + (unsigned)r32) * 4u;
#pragma unroll
    for (int i = 0; i < 4; ++i)
#pragma unroll
        for (int q = 0; q < 16; ++q) *(GAS float*)((GAS char*)uni(so + (size_t)(32 * i + (q & 3) + 8 * (q >> 2)) * 256) + soff) = S[i][q];
    if (w == 0) *(f32x2*)(DT + (size_t)idx * 128 + ch0) = (f32x2){bt0s, bt1s};
    BAR_LDS();
}

DI void rec_prompt(LAS unsigned char* lds, int tid, int w, int lane, int l, int unit, const bf16* proj, const float* loga, const float* logh, const float* head_norm,
                   const float* DS, const float* DT, bf16* ON, float* out) {
    const int seq = unit >> 2, seg = unit & 3;
    const int r = seq >> 4, b = (seq >> 2) & 3, hd = seq & 3;
    const int ch0 = 2 * lane, h = lane >> 5, r32 = lane & 31, V0 = 32 * w;
    const int qcol = 3072 * r + hd * 128 + ch0, kcol = qcol + 512, vcolbase = 3072 * r + 1024 + hd * 256, gcolbase = 3072 * r + 2048 + hd * 256;
    const float* lg = r == 2 ? logh : loga;
    const float gret = __builtin_amdgcn_logf(1.0f - ex2(-5.0f - (float)hd));
    for (int e = tid; e < 9216 / 4; e += NWAVES * 64) ((LAS unsigned*)(lds + R_P))[e] = 0u;
    const unsigned soff = ((unsigned)(4 * h) * 256u + (unsigned)r32) * 4u;
    f32x16 S[4];
#pragma unroll
    for (int i = 0; i < 4; ++i)
#pragma unroll
        for (int q = 0; q < 16; ++q) S[i][q] = 0.f;
    for (int j = 0; j < seg; ++j) { const float* dsj = DS + (size_t)(seq * (NSEG - 1) + j) * 32768 + V0; const float* dtj = DT + (size_t)(seq * (NSEG - 1) + j) * 128;
#pragma unroll
        for (int ih = 0; ih < 2; ++ih) {
            f32x4 dl[2][4], dv[2][4];
#pragma unroll
            for (int ii = 0; ii < 2; ++ii)
#pragma unroll
                for (int g = 0; g < 4; ++g) { const int i = 2 * ih + ii; dl[ii][g] = *(const f32x4*)(dtj + 32 * i + 8 * g + 4 * h);
#pragma unroll
                    for (int e = 0; e < 4; ++e) { const int q = 4 * g + e; dv[ii][g][e] = *(const GAS float*)(uni(dsj + (size_t)(32 * i + (q & 3) + 8 * (q >> 2)) * 256) + soff); } }
            asm volatile("" : "+v"(dl[0][0]), "+v"(dl[0][1]), "+v"(dl[0][2]), "+v"(dl[0][3]), "+v"(dl[1][0]), "+v"(dl[1][1]), "+v"(dl[1][2]), "+v"(dl[1][3]),
                              "+v"(dv[0][0]), "+v"(dv[0][1]), "+v"(dv[0][2]), "+v"(dv[0][3]), "+v"(dv[1][0]), "+v"(dv[1][1]), "+v"(dv[1][2]), "+v"(dv[1][3]));
#pragma unroll
            for (int ii = 0; ii < 2; ++ii)
#pragma unroll
                for (int g = 0; g < 4; ++g)
#pragma unroll
                    for (int e = 0; e < 4; ++e) { const int q = 4 * g + e; S[2 * ih + ii][q] = S[2 * ih + ii][q] * ex2(dl[ii][g][e]) + dv[ii][g][e]; } } }
    bf16* ONr = ON + (size_t)r * MROWS * 1024;
    const int posq = (ch0 & ~12) | ((ch0 & 4) << 1) | ((ch0 & 8) >> 1);
    const int jb = w >> 1;
    unsigned rq[8], rk[8]; f32x2 rx[8];
#pragma unroll
    for (int i = 0; i < 8; ++i) rx[i] = (f32x2){0.f, 0.f};
    const int vrow = (tid >> 5) & 1, vc8 = (tid & 31) * 8;
    const unsigned qoff = (unsigned)qcol * 2u, koff = (unsigned)kcol * 2u, lgoff = (unsigned)ch0 * 4u;
    const unsigned voff = ((unsigned)vrow * NPROJ + (unsigned)vc8) * 2u, goff = ((unsigned)r32 * NPROJ + 4u * (unsigned)h) * 2u, ooff = ((unsigned)r32 * 1024u + 4u * (unsigned)h) * 2u;
#define REC_LOAD(n_) do { const int ng_ = CPS * seg + (n_); const size_t row0_ = (size_t)b * SEQ + 64 * ng_; \
        _Pragma("unroll") for (int i = 0; i < 8; ++i) { gcp_t pb_ = uni(proj + (row0_ + 8 * w + i) * NPROJ); \
            rq[i] = *(const GAS unsigned*)(pb_ + qoff); rk[i] = *(const GAS unsigned*)(pb_ + koff); \
            if (r != 0) rx[i] = *(const GAS f32x2*)(uni(lg + (row0_ + 8 * w + i) * 512 + hd * 128) + lgoff); } } while (0)
    REC_LOAD(0);
    { unsigned zv = 0u; asm volatile("" : "+v"(zv));
#pragma unroll
      for (int i = 0; i < 8; ++i) { rq[i] ^= zv; rk[i] ^= zv; rx[i].x = __uint_as_float(__float_as_uint(rx[i].x) ^ zv); rx[i].y = __uint_as_float(__float_as_uint(rx[i].y) ^ zv); } }
    v4u vr[4];
#define REC_VLOAD(n_) do { const size_t rowv_ = (size_t)b * SEQ + 64 * (CPS * seg + (n_)); \
        _Pragma("unroll") for (int i = 0; i < 4; ++i) vr[i] = *(const GAS v4u*)(uni(proj + (rowv_ + 16 * i + 2 * w) * NPROJ + vcolbase) + voff); } while (0)
    REC_VLOAD(0);
    v2u gt[2][4];
#define REC_GLOAD(n_) do { const size_t rowg_ = (size_t)b * SEQ + 64 * (CPS * seg + (n_)); \
        _Pragma("unroll") for (int tt = 0; tt < 2; ++tt) _Pragma("unroll") for (int g = 0; g < 4; ++g) gt[tt][g] = *(const GAS v2u*)(uni(proj + (rowg_ + 32 * tt) * NPROJ + gcolbase + V0 + 8 * g) + goff); } while (0)
    REC_GLOAD(0);
    for (int n = 0; n < CPS; ++n) {
        const size_t row0 = (size_t)b * SEQ + 64 * (CPS * seg + n);
        float c0[8], c1[8];
        float cs0 = 0.f, cs1 = 0.f;
#pragma unroll
        for (int i = 0; i < 8; ++i) { const float G0 = r == 0 ? gret : rx[i].x, G1 = r == 0 ? gret : rx[i].y; cs0 += G0; cs1 += G1; c0[i] = cs0; c1[i] = cs1; }
        *(LAS f32x2*)(lds + R_WT + (w * 128 + ch0) * 4) = (f32x2){cs0, cs1};
        BAR_LDS();
        float B0[5], B1[5], st0 = 0.f, st1 = 0.f;
        { float p0 = 0.f, p1 = 0.f; B0[0] = 0.f; B1[0] = 0.f;
#pragma unroll
          for (int ww = 0; ww < 8; ++ww) { const f32x2 t = *(const LAS f32x2*)(lds + R_WT + (ww * 128 + ch0) * 4);
              if (ww == w) { st0 = p0; st1 = p1; }
              p0 += t.x; p1 += t.y; if (ww & 1) { B0[(ww + 1) >> 1] = p0; B1[(ww + 1) >> 1] = p1; } } }
        const float Bj0 = jb == 0 ? B0[0] : jb == 1 ? B0[1] : jb == 2 ? B0[2] : B0[3], Bj1 = jb == 0 ? B1[0] : jb == 1 ? B1[1] : jb == 2 ? B1[2] : B1[3];
        const float Bn0 = jb == 0 ? B0[1] : jb == 1 ? B0[2] : jb == 2 ? B0[3] : B0[4], Bn1 = jb == 0 ? B1[1] : jb == 1 ? B1[2] : jb == 2 ? B1[3] : B1[4];
        float fo0[5], fo1[5];
#pragma unroll
        for (int i = 1; i < 5; ++i) { fo0[i] = ex2(fminf(B0[i] - Bn0, 0.f)); fo1[i] = ex2(fminf(B1[i] - Bn1, 0.f)); }
        const float EB0 = ex2(Bj0), EB1 = ex2(Bj1), FB0 = ex2(Bn0 - Bj0), FB1 = ex2(Bn1 - Bj1);
        unsigned ku0[4], ku1[4];
#pragma unroll
        for (int i = 0; i < 8; ++i) {
            const int t = 8 * w + i;
            const float q0i = bflo(rq[i]), q1i = bfhi(rq[i]), k0i = bflo(rk[i]), k1i = bfhi(rk[i]);
            const float bt0 = st0 + c0[i], bt1 = st1 + c1[i];
            const float qd0 = q0i * ex2(bt0 - Bj0), qd1 = q1i * ex2(bt1 - Bj1);
            const float kd0 = k0i * ex2(fminf(Bj0 - bt0, 120.f)), kd1 = k1i * ex2(fminf(Bj1 - bt1, 120.f));
            *(LAS unsigned*)(lds + R_QD + t * 272 + ch0 * 2) = pk2(qd0, qd1);
            *(LAS unsigned*)(lds + R_QI + t * 272 + posq * 2) = pk2(qd0 * EB0, qd1 * EB1);
            *(LAS unsigned*)(lds + R_KD + t * 272 + ch0 * 2) = pk2(kd0, kd1);
            const float kb0 = kd0 * FB0, kb1 = kd1 * FB1;
            if (jb < 1) *(LAS unsigned*)(lds + R_KO + (0 + t) * 272 + ch0 * 2) = pk2(kb0 * fo0[1], kb1 * fo1[1]);
            if (jb < 2) *(LAS unsigned*)(lds + R_KO + (16 + t) * 272 + ch0 * 2) = pk2(kb0 * fo0[2], kb1 * fo1[2]);
            if (jb < 3) *(LAS unsigned*)(lds + R_KO + (48 + t) * 272 + ch0 * 2) = pk2(kb0 * fo0[3], kb1 * fo1[3]);
            const float u0 = kb0 * fo0[4], u1 = kb1 * fo1[4];
            if (i & 1) { ku0[i >> 1] |= pk2(0.f, u0) ; ku1[i >> 1] |= pk2(0.f, u1); } else { ku0[i >> 1] = pk2(u0, 0.f); ku1[i >> 1] = pk2(u1, 0.f); }
            asm volatile("" ::: "memory");
        }
        *(LAS v4u*)(lds + R_KU + ch0 * 144 + 16 * w) = (v4u){ku0[0], ku0[1], ku0[2], ku0[3]};
        *(LAS v4u*)(lds + R_KU + (ch0 + 1) * 144 + 16 * w) = (v4u){ku1[0], ku1[1], ku1[2], ku1[3]};
        if (w == 0) *(LAS f32x2*)(lds + R_DEC + ch0 * 4) = (f32x2){ex2(B0[4]), ex2(B1[4])};
        REC_LOAD(n + 1 < CPS ? n + 1 : n);
        BAR_LDS();
        {
            const int nblk = (w == 4 || w == 5) ? 2 : 1;
            for (int bi = 0; bi < nblk; ++bi) {
                int bI, bJ;
                if (bi == 0) { bI = w < 4 ? w : (w == 4 ? 1 : (w == 7 ? 3 : 2)); bJ = w < 4 ? w : (w == 6 ? 1 : 0); } else { bI = 3; bJ = w == 4 ? 1 : 2; }
                const int kobase = bI == 1 ? 0 : (bI == 2 ? 16 : 48);
                const int kxoff = (bI == bJ) ? R_KD + (16 * bJ) * 272 : R_KO + (kobase + 16 * bJ) * 272;
                f32x4 pa = {0.f, 0.f, 0.f, 0.f};
#pragma unroll
                for (int ks = 0; ks < 4; ++ks) {
                    const bf16x8 af = *(const LAS bf16x8*)(lds + kxoff + (lane & 15) * 272 + (32 * ks + 8 * (lane >> 4)) * 2);
                    const bf16x8 bfr = *(const LAS bf16x8*)(lds + R_QD + (16 * bI + (lane & 15)) * 272 + (32 * ks + 8 * (lane >> 4)) * 2);
                    pa = MFMA16(af, bfr, pa);
                }
                if (bI == bJ) {
#pragma unroll
                    for (int q = 0; q < 4; ++q) if (4 * (lane >> 4) + q > (lane & 15)) pa[q] = 0.f;
                }
                *(LAS v2u*)(lds + R_P + (16 * bI + (lane & 15)) * 144 + (16 * bJ + 4 * (lane >> 4)) * 2) = (v2u){pk2(pa[0], pa[1]), pk2(pa[2], pa[3])};
            }
        }
#pragma unroll
        for (int i = 0; i < 4; ++i) *(LAS v4u*)(lds + R_V + (2 * w + vrow + 16 * i) * 576 + vc8 * 2) = vr[i];
        REC_VLOAD(n + 1 < CPS ? n + 1 : n);
        BAR_LDS();
        bf16x8 vf[4];
        { const int g16 = (lane >> 4) & 1, q4 = (lane & 15) >> 2, p4 = lane & 3;
#pragma unroll
          for (int ks = 0; ks < 4; ++ks) { const int off = R_V + (16 * ks + 8 * h + q4) * 576 + (V0 + 16 * g16 + 4 * p4) * 2;
              const s16x4 lo = __builtin_amdgcn_ds_read_tr16_b64_v4i16((LAS s16x4*)(lds + off)), hi = __builtin_amdgcn_ds_read_tr16_b64_v4i16((LAS s16x4*)(lds + off + 4 * 576));
              vf[ks] = __builtin_shufflevector(lo, hi, 0, 1, 2, 3, 4, 5, 6, 7); } }
        f32x16 OT[2];
#pragma unroll
        for (int tt = 0; tt < 2; ++tt)
#pragma unroll
            for (int q = 0; q < 16; ++q) OT[tt][q] = 0.f;
#pragma unroll
        for (int i = 0; i < 4; ++i)
#pragma unroll
            for (int s = 0; s < 2; ++s) {
                v4u sp; sp.x = pk2(S[i][8 * s], S[i][8 * s + 1]); sp.y = pk2(S[i][8 * s + 2], S[i][8 * s + 3]); sp.z = pk2(S[i][8 * s + 4], S[i][8 * s + 5]); sp.w = pk2(S[i][8 * s + 6], S[i][8 * s + 7]);
                const bf16x8 sa = __builtin_bit_cast(bf16x8, sp);
#pragma unroll
                for (int tt = 0; tt < 2; ++tt) { const bf16x8 qf = *(const LAS bf16x8*)(lds + R_QI + (32 * tt + r32) * 272 + (32 * i + 16 * s + 8 * h) * 2);
                    OT[tt] = MFMA32(sa, qf, OT[tt]); }
                asm volatile("" ::: "memory"); }
#pragma unroll
        for (int tt = 0; tt < 2; ++tt)
#pragma unroll
            for (int ks = 0; ks < 4; ++ks) if (tt == 1 || ks < 2) { const bf16x8 pf = *(const LAS bf16x8*)(lds + R_P + (32 * tt + r32) * 144 + (16 * ks + 8 * h) * 2);
                OT[tt] = MFMA32(vf[ks], pf, OT[tt]); }
#pragma unroll
        for (int i = 0; i < 4; ++i) {
#pragma unroll
            for (int g = 0; g < 4; ++g) { const f32x4 dc = *(const LAS f32x4*)(lds + R_DEC + (32 * i + 8 * g + 4 * h) * 4);
                S[i][4 * g] *= dc.x; S[i][4 * g + 1] *= dc.y; S[i][4 * g + 2] *= dc.z; S[i][4 * g + 3] *= dc.w; }
#pragma unroll
            for (int ks = 0; ks < 4; ++ks) { const bf16x8 kf = *(const LAS bf16x8*)(lds + R_KU + (32 * i + r32) * 144 + (16 * ks + 8 * h) * 2);
                S[i] = MFMA32(kf, vf[ks], S[i]); }
            asm volatile("" ::: "memory");
        }
#pragma unroll
        for (int tt = 0; tt < 2; ++tt) { float ss = 0.f;
#pragma unroll
            for (int q = 0; q < 16; ++q) ss += OT[tt][q] * OT[tt][q];
            ss += __shfl_xor(ss, 32);
            if (lane < 32) *(LAS float*)(lds + R_SS + (w * 64 + 32 * tt + lane) * 4) = ss; }
        BAR_LDS();
        { unsigned zv = 0u; asm volatile("" : "+v"(zv));
#pragma unroll
          for (int i = 0; i < 8; ++i) { rq[i] ^= zv; rk[i] ^= zv; rx[i].x = __uint_as_float(__float_as_uint(rx[i].x) ^ zv); rx[i].y = __uint_as_float(__float_as_uint(rx[i].y) ^ zv); } }
        asm volatile("" : "+v"(rq[0]), "+v"(rq[1]), "+v"(rq[2]), "+v"(rq[3]), "+v"(rq[4]), "+v"(rq[5]), "+v"(rq[6]), "+v"(rq[7]),
                          "+v"(rk[0]), "+v"(rk[1]), "+v"(rk[2]), "+v"(rk[3]), "+v"(rk[4]), "+v"(rk[5]), "+v"(rk[6]), "+v"(rk[7]),
                          "+v"(rx[0]), "+v"(rx[1]), "+v"(rx[2]), "+v"(rx[3]), "+v"(rx[4]), "+v"(rx[5]), "+v"(rx[6]), "+v"(rx[7]) : : "memory");
#pragma unroll
        for (int tt = 0; tt < 2; ++tt) { float tot = 0.f;
#pragma unroll
            for (int ww = 0; ww < 8; ++ww) tot += *(const LAS float*)(lds + R_SS + (ww * 64 + 32 * tt + r32) * 4);
            const float rstd = 1.0f / sqrtf(tot * (1.0f / 256.0f) + EPS);
            GAS char* orow = (GAS char*)uni(ONr + (row0 + 32 * tt) * 1024 + hd * 256 + V0) + ooff;
#pragma unroll
            for (int g = 0; g < 4; ++g) { const v2u gg = gt[tt][g];
                const float y0 = OT[tt][4 * g] * rstd * bflo(gg.x), y1 = OT[tt][4 * g + 1] * rstd * bfhi(gg.x);
                const float y2 = OT[tt][4 * g + 2] * rstd * bflo(gg.y), y3 = OT[tt][4 * g + 3] * rstd * bfhi(gg.y);
                *(GAS v2u*)(orow + 16 * g) = (v2u){pk2(y0, y1), pk2(y2, y3)}; } }
        REC_GLOAD(n + 1 < CPS ? n + 1 : n);
    }
#undef REC_LOAD
    if (seg == NSEG - 1) {
        const unsigned soffF = r == 0 ? ((unsigned)h * 16384u + (unsigned)r32) * 4u : soff;
        float* so = out + O_PST + (size_t)r * 1048576 + ((size_t)(l * 4 + b) * 4 + hd) * 32768 + V0;
#pragma unroll
        for (int i = 0; i < 4; ++i)
#pragma unroll
            for (int q = 0; q < 16; ++q) {
                const int urow = r == 0 ? 16 * i + 4 * (q >> 2) + (q & 3) : 32 * i + (q & 3) + 8 * (q >> 2);
                *(GAS float*)((GAS char*)uni(so + (size_t)urow * 256) + soffF) = S[i][q]; }
    }
    BAR_LDS();
}
struct DecP { unsigned pqa, pka, pv2, pg2; float plg; };
DI void rec_sample_run(LAS unsigned char* lds, int tid, int w, int lane, int l, int idx, int qbase, int su_off, int qend, int qoff, unsigned* queue, const bf16* proj, const float* loga, const float* logh,
                       const float* head_norm, const float* st0, const float* st1, const float* st2, bf16* ON, float* out) {
    LAS float* PAR = (LAS float*)lds; LAS float* VS = (LAS float*)(lds + 6144); LAS float* PO = (LAS float*)(lds + 10240); LAS float* SS2 = (LAS float*)(lds + 43008);
    volatile LAS int* qslot = (volatile LAS int*)(lds + LDS_MISC + 16);
    const unsigned loff = 16u * (unsigned)lane;
    const int ta = tid >> 7, cha = tid & 127;
    const int tc = w >> 1, cc = 128 * (w & 1) + 2 * lane;
    f32x4 sA[16], sB[16]; DecP pA, pB;
#define S_ISSUE(s_, p_, su_) do { const int r_ = (su_) >> 9, b_ = ((su_) >> 2) & 127, hd_ = (su_) & 3; const size_t row_ = (size_t)TP + 4 * b_ + ta, rowc_ = (size_t)TP + 4 * b_ + tc; \
        const bf16* pr_ = proj + row_ * NPROJ + 3072 * r_ + hd_ * 128 + cha; p_.pqa = pr_[0]; p_.pka = pr_[512]; \
        p_.plg = r_ == 0 ? 0.f : (r_ == 2 ? logh : loga)[row_ * 512 + hd_ * 128 + cha]; \
        p_.pv2 = *(const unsigned*)(proj + row_ * NPROJ + 3072 * r_ + 1024 + hd_ * 256 + 2 * cha); \
        p_.pg2 = *(const unsigned*)(proj + rowc_ * NPROJ + 3072 * r_ + 2048 + hd_ * 256 + cc); \
        const float* S0_ = (r_ == 0 ? st0 : (r_ == 1 ? st1 : st2)) + ((size_t)(l * 128 + b_) * 4 + hd_) * 32768 + (size_t)(16 * w) * 256; \
        _Pragma("unroll") for (int rr = 0; rr < 16; ++rr) s_[rr] = __builtin_nontemporal_load((const GAS f32x4*)(uni(S0_ + rr * 256) + loff)); } while (0)
    constexpr int SSH = (REPMASK >> 13) & 1;
    int su = ((idx - qbase) >> SSH) + su_off;
    S_ISSUE(sA, pA, su);
    if (tid == 0) *qslot = qoff + (int)__hip_atomic_fetch_add(queue, 1u, __ATOMIC_RELAXED, __HIP_MEMORY_SCOPE_AGENT);
    BAR_LDS();
    int nidx = __builtin_amdgcn_readfirstlane(*qslot);
    BAR_LDS();
    for (;;) {
#pragma unroll
        for (int ph = 0; ph < 2; ++ph) {
            f32x4 (&s)[16] = ph ? sB : sA; f32x4 (&sn)[16] = ph ? sA : sB; DecP& p = ph ? pB : pA; DecP& pn = ph ? pA : pB;
            const bool has_next = nidx < qend;
            const int nsu = ((nidx - qbase) >> SSH) + su_off;
            int nraw = qend;
            if (tid == 0 && has_next) nraw = qoff + (int)__hip_atomic_fetch_add(queue, 1u, __ATOMIC_RELAXED, __HIP_MEMORY_SCOPE_AGENT);
            if (has_next) S_ISSUE(sn, pn, nsu);
            const int r = su >> 9, b = (su >> 2) & 127, hd = su & 3;
            const size_t rowb = (size_t)TP + 4 * b;
            {
                const float f = r == 0 ? 1.0f - ex2(-5.0f - (float)hd) : ex2(p.plg);
                const int chs = r == 0 ? rope_chan(cha) : cha;
                PAR[chs * 12 + ta] = f; PAR[chs * 12 + 4 + ta] = bflo(p.pka); PAR[chs * 12 + 8 + ta] = bflo(p.pqa);
                VS[ta * 256 + 2 * cha] = bflo(p.pv2); VS[ta * 256 + 2 * cha + 1] = bfhi(p.pv2);
            }
            const unsigned cg2 = p.pg2;
            BAR_LDS();
            f32x4 vv[4], oa[4];
#pragma unroll
            for (int t = 0; t < 4; ++t) { vv[t] = *(const LAS f32x4*)(VS + t * 256 + 4 * lane); oa[t] = (f32x4){0.f, 0.f, 0.f, 0.f}; }
            float* So = out + O_SST + (size_t)r * 33554432 + ((size_t)(l * 128 + b) * 4 + hd) * 32768 + (size_t)(16 * w) * 256;
#pragma unroll
            for (int rr = 0; rr < 16; ++rr) { const LAS float* pp = PAR + (16 * w + rr) * 12;
                const f32x4 ff = *(const LAS f32x4*)pp, kk = *(const LAS f32x4*)(pp + 4), qq = *(const LAS f32x4*)(pp + 8);
                f32x4 x = s[rr];
                x = x * ff.x + vv[0] * kk.x; oa[0] += x * qq.x;
                x = x * ff.y + vv[1] * kk.y; oa[1] += x * qq.y;
                x = x * ff.z + vv[2] * kk.z; oa[2] += x * qq.z;
                x = x * ff.w + vv[3] * kk.w; oa[3] += x * qq.w;
                __builtin_nontemporal_store(x, (GAS f32x4*)((GAS char*)uni(So + rr * 256) + loff)); asm volatile("" ::: "memory"); }
#pragma unroll
            for (int t = 0; t < 4; ++t) *(LAS f32x4*)(PO + (w * 4 + t) * 256 + 4 * lane) = oa[t];
            if (tid == 0) *qslot = nraw;
            BAR_LDS();
            const int nidx2 = __builtin_amdgcn_readfirstlane(*qslot);
            {
                float o0 = 0.f, o1 = 0.f;
#pragma unroll
                for (int ww = 0; ww < 8; ++ww) { const f32x2 pq = *(const LAS f32x2*)(PO + (ww * 4 + tc) * 256 + cc); o0 += pq.x; o1 += pq.y; }
                const float ssw = wave_sum(o0 * o0 + o1 * o1);
                if (lane == 0) SS2[w] = ssw;
                BAR_LDS();
                const float rstd = 1.0f / sqrtf((SS2[2 * tc] + SS2[2 * tc + 1]) * (1.0f / 256.0f) + EPS);
                *(unsigned*)(ON + (size_t)r * MROWS * 1024 + (rowb + tc) * 1024 + hd * 256 + cc) = pk2(o0 * rstd * bflo(cg2), o1 * rstd * bfhi(cg2));
            }
            BAR_LDS();
            if (!has_next) goto dec_done;
            su = nsu; nidx = nidx2;
        }
    }
dec_done: ;
#undef S_ISSUE
}
DI void rec_phase(LAS unsigned char* lds, int tid, int w, int lane, int l, int blk, int G, unsigned* queue, const XcdBarrier& bar, const bf16* proj, const float* loga, const float* logh, const float* head_norm,
                  const float* st0, const float* st1, const float* st2, float* DS, float* DT, bf16* ON, float* out) {
    volatile LAS int* qslot = (volatile LAS int*)(lds + LDS_MISC + 16);
    constexpr int NP1 = 48 * (NSEG - 1), NP2 = 48 * NSEG, SSH = (REPMASK >> 13) & 1, PSH = (REPMASK >> 12) & 1;
    for (bool first = true;; first = false) {
        int idx = blk;
        if (!first) {
            if (tid == 0) *qslot = G + (int)__hip_atomic_fetch_add(queue, 1u, __ATOMIC_RELAXED, __HIP_MEMORY_SCOPE_AGENT);
            __syncthreads();
            idx = __builtin_amdgcn_readfirstlane(*qslot);
            __syncthreads(); }
        if (idx >= NP1 + (NSA << SSH)) break;
        if (idx < NP1) { for (int rep = 0; rep < NREP(14); ++rep) rec_state(lds, tid, w, lane, l, idx, proj, loga, logh, DS, DT); }
        else { rec_sample_run(lds, tid, w, lane, l, idx, NP1, 0, NP1 + (NSA << SSH), G, queue, proj, loga, logh, head_norm, st0, st1, st2, ON, out); break; }
    }
    xcd_barrier(bar);
    for (bool first = true;; first = false) {
        int idx = blk;
        if (!first) {
            if (tid == 0) *qslot = G + (int)__hip_atomic_fetch_add(queue + 32, 1u, __ATOMIC_RELAXED, __HIP_MEMORY_SCOPE_AGENT);
            __syncthreads();
            idx = __builtin_amdgcn_readfirstlane(*qslot);
            __syncthreads(); }
        if (idx >= (NP2 << PSH) + ((1536 - NSA) << SSH)) break;
        if (idx < (NP2 << PSH)) rec_prompt(lds, tid, w, lane, l, idx >> PSH, proj, loga, logh, head_norm, DS, DT, ON, out);
        else { rec_sample_run(lds, tid, w, lane, l, idx, (NP2 << PSH), NSA, (NP2 << PSH) + ((1536 - NSA) << SSH), G, queue + 32, proj, loga, logh, head_norm, st0, st1, st2, ON, out); break; }
    }
}
DI void conv_fix_phase(int gtid, int NT, int l, const float* UH, const float* cw, const float* cb, bf16* ACT, float* out) {
    constexpr int NQ = DFF / 4;
    for (int idx = gtid; idx < 32 * 2 * NQ; idx += NT) {
        const int cq = idx % NQ, g = (idx / NQ) & 1, pm = idx / (2 * NQ), cl = 4 * cq;
        const f32x4 wa0 = *(const f32x4*)(cw + cl), wa1 = *(const f32x4*)(cw + NUP + cl), wa2 = *(const f32x4*)(cw + 2 * NUP + cl), ba = *(const f32x4*)(cb + cl);
        const f32x4 wb0 = *(const f32x4*)(cw + DFF + cl), wb1 = *(const f32x4*)(cw + NUP + DFF + cl), wb2 = *(const f32x4*)(cw + 2 * NUP + DFF + cl), bb = *(const f32x4*)(cb + DFF + cl);
        f32x4 a2 = {0.f, 0.f, 0.f, 0.f}, a1 = a2, b2 = a2, b1 = a2;
        const float* hist = g == 1 ? UH + ((size_t)pm * 8 + 2) * NUP : ((pm & 7) != 0 ? UH + ((size_t)(pm - 1) * 8 + 6) * NUP : nullptr);
        if (hist) { a2 = *(const f32x4*)(hist + cl); b2 = *(const f32x4*)(hist + DFF + cl); a1 = *(const f32x4*)(hist + NUP + cl); b1 = *(const f32x4*)(hist + NUP + DFF + cl); }
        const float* own = UH + ((size_t)pm * 8 + 4 * g) * NUP;
#pragma unroll
        for (int j = 0; j < 2; ++j) {
            const f32x4 a0 = *(const f32x4*)(own + (size_t)j * NUP + cl), b0 = *(const f32x4*)(own + (size_t)j * NUP + DFF + cl);
            const f32x4 ca = ba + wa0 * a2 + wa1 * a1 + wa2 * a0, cbv = bb + wb0 * b2 + wb1 * b1 + wb2 * b0;
            *(v2u*)(ACT + (size_t)(256 * pm + 128 * g + j) * DFF + cl) = (v2u){pk2(silu(ca[0]) * cbv[0], silu(ca[1]) * cbv[1]), pk2(silu(ca[2]) * cbv[2], silu(ca[3]) * cbv[3])};
            a2 = a1; a1 = a0; b2 = b1; b1 = b0; }
        if (g == 1 && (pm & 7) == 7) {
            const float* last = UH + ((size_t)pm * 8 + 6) * NUP; float* so = out + O_PCONV + ((size_t)(l * 4 + (pm >> 3)) * 2) * NUP;
            const f32x4 c0 = *(const f32x4*)(last + cl), c1 = *(const f32x4*)(last + DFF + cl), c2 = *(const f32x4*)(last + NUP + cl), c3 = *(const f32x4*)(last + NUP + DFF + cl);
            *(f32x4*)(so + cl) = c0; *(f32x4*)(so + DFF + cl) = c1; *(f32x4*)(so + NUP + cl) = c2; *(f32x4*)(so + NUP + DFF + cl) = c3;
        }
    }
}
template <int MODE>
DI void sgemm_phase(LAS unsigned char* lds, int blk, int G, int tid, int w, int lane, const bf16* A, size_t a_bstride, const bf16* Bt, size_t b_bstride, int K,
                    bf16* XA, const float* xin_s, const float* gvec, const bf16* gate, bf16* MB) {
    constexpr int ROWB = 528, OPB = 64 * ROWB, SA = 0, SB = 2 * OPB, SRED = 4 * OPB, SGT = SRED, ST = 0, TROW = 272;
    static_assert(SRED + 16384 <= LDS_MISC, "sgemm LDS map");
    const int r32 = lane & 31, h = lane >> 5, quad = w & 3, kh = w >> 2, srow = tid >> 3, skc = (tid & 7) * 8;
    const int nsteps = K / 256;
    for (int tile = blk; tile < 256; tile += G) {
        const int tm = (tile & 31) >> 2, tn = (tile >> 5) * 4 + (tile & 3);
        const int R0 = TP + 64 * tm, C0 = 64 * tn;
        const int erow = R0 + srow, ecol = C0 + skc;
        f32x4 x0 = {0.f, 0.f, 0.f, 0.f}, x1 = x0, g0 = x0, g1 = x0;
        if (MODE == 0) {
            if (xin_s) { const float* xp_ = xin_s + (size_t)(erow - TP) * D + ecol; x0 = *(const f32x4*)xp_; x1 = *(const f32x4*)(xp_ + 4); }
            else { const v4u xr = *(const v4u*)(XA + (size_t)erow * D + ecol); x0[0] = bflo(xr.x); x0[1] = bfhi(xr.x); x0[2] = bflo(xr.y); x0[3] = bfhi(xr.y); x1[0] = bflo(xr.z); x1[1] = bfhi(xr.z); x1[2] = bflo(xr.w); x1[3] = bfhi(xr.w); }
            const float* gp_ = gvec + (size_t)bidx_of(erow) * NMOD + ecol; g0 = *(const f32x4*)gp_; g1 = *(const f32x4*)(gp_ + 4);
        }
        f32x16 tot;
#pragma unroll
        for (int q = 0; q < 16; ++q) tot[q] = 0.f;
        const int nb = MODE == 1 ? 3 : 1;
        for (int br = 0; br < nb; ++br) {
            const bf16* ap = A + br * a_bstride + (size_t)(R0 + srow) * K + skc;
            const bf16* bp = Bt + br * b_bstride + (size_t)(C0 + srow) * K + skc;
            f32x16 acc;
#pragma unroll
            for (int q = 0; q < 16; ++q) acc[q] = 0.f;
            v4u ra[4], rb[4], na[4], nb2[4];
            v4u gt = {0u, 0u, 0u, 0u};
            if (MODE == 1) gt = *(const v4u*)(gate + (size_t)erow * NPROJ + br * D + ecol);
#pragma unroll
            for (int j = 0; j < 4; ++j) { ra[j] = *(const v4u*)(ap + 64 * j); rb[j] = *(const v4u*)(bp + 64 * j); }
            if (MODE == 1) *(LAS v4u*)(lds + SGT + (br & 1) * 8192 + srow * 128 + skc * 2) = gt;
#pragma unroll
            for (int j = 0; j < 4; ++j) { *(LAS v4u*)(lds + SA + srow * ROWB + (skc + 64 * j) * 2) = ra[j]; *(LAS v4u*)(lds + SB + srow * ROWB + (skc + 64 * j) * 2) = rb[j]; }
            if (nsteps > 1) {
#pragma unroll
                for (int j = 0; j < 4; ++j) { ra[j] = *(const v4u*)(ap + 256 + 64 * j); rb[j] = *(const v4u*)(bp + 256 + 64 * j); } }
            __syncthreads();
            for (int st = 0; st < nsteps; ++st) {
                const int cur = st & 1;
                if (st + 2 < nsteps) {
#pragma unroll
                    for (int j = 0; j < 4; ++j) { na[j] = *(const v4u*)(ap + (st + 2) * 256 + 64 * j); nb2[j] = *(const v4u*)(bp + (st + 2) * 256 + 64 * j); } }
#pragma unroll
                for (int j = 0; j < 8; ++j) {
                    const bf16x8 af = *(const LAS bf16x8*)(lds + SA + cur * OPB + (32 * (quad >> 1) + r32) * ROWB + (128 * kh + 16 * j + 8 * h) * 2);
                    const bf16x8 bfr = *(const LAS bf16x8*)(lds + SB + cur * OPB + (32 * (quad & 1) + r32) * ROWB + (128 * kh + 16 * j + 8 * h) * 2);
                    acc = MFMA32(af, bfr, acc); }
                if (st + 1 < nsteps) {
#pragma unroll
                    for (int j = 0; j < 4; ++j) { *(LAS v4u*)(lds + SA + (cur ^ 1) * OPB + srow * ROWB + (skc + 64 * j) * 2) = ra[j]; *(LAS v4u*)(lds + SB + (cur ^ 1) * OPB + srow * ROWB + (skc + 64 * j) * 2) = rb[j]; } }
#pragma unroll
                for (int j = 0; j < 4; ++j) { ra[j] = na[j]; rb[j] = nb2[j]; }
                BAR_LDS();
            }
            if (MODE == 1) {
#pragma unroll
                for (int q = 0; q < 16; ++q) { const int rl = 32 * (quad >> 1) + (q & 3) + 8 * (q >> 2) + 4 * h;
                    const float gv = bflo((unsigned)*(const LAS unsigned short*)(lds + SGT + (br & 1) * 8192 + rl * 128 + (32 * (quad & 1) + r32) * 2));
                    tot[q] += sigm(gv) * acc[q]; }
            } else tot = acc;
        }
        LAS float* red = (LAS float*)(lds + SRED) + (quad * 16) * 64;
        if (MODE == 1) __syncthreads();
        if (kh == 1) {
#pragma unroll
            for (int q = 0; q < 16; ++q) red[q * 64 + lane] = tot[q];
        }
        __syncthreads();
        if (kh == 0) {
#pragma unroll
            for (int q = 0; q < 16; ++q) { const int rl = 32 * (quad >> 1) + (q & 3) + 8 * (q >> 2) + 4 * h, cl = 32 * (quad & 1) + r32;
                *(LAS float*)(lds + ST + rl * TROW + cl * 4) = tot[q] + red[q * 64 + lane]; }
        }
        __syncthreads();
        { const f32x4 t0 = *(const LAS f32x4*)(lds + ST + srow * TROW + skc * 4), t1 = *(const LAS f32x4*)(lds + ST + srow * TROW + skc * 4 + 16);
          v4u o;
          if (MODE == 0) { const f32x4 y0 = x0 + g0 * t0, y1 = x1 + g1 * t1; o.x = pk2(y0[0], y0[1]); o.y = pk2(y0[2], y0[3]); o.z = pk2(y1[0], y1[1]); o.w = pk2(y1[2], y1[3]);
              *(v4u*)((MB ? MB : XA) + (size_t)erow * D + ecol) = o; }
          else { o.x = pk2(t0[0], t0[1]); o.y = pk2(t0[2], t0[3]); o.z = pk2(t1[0], t1[1]); o.w = pk2(t1[2], t1[3]); *(v4u*)(MB + (size_t)erow * D + ecol) = o; } }
        __syncthreads();
    }
}
constexpr int NPH = 21;
struct Args { const float* in[24]; float* out; unsigned char* ws; int ph_lo, ph_hi; };
__global__ void __launch_bounds__(NWAVES * 64, 2) mega(Args args) {
    extern __shared__ __attribute__((aligned(16))) unsigned char lds_raw[];
    LAS unsigned char* lds = (LAS unsigned char*)lds_raw;
    const int tid0 = threadIdx.x, wave0 = __builtin_amdgcn_readfirstlane(tid0 >> 6);
    const int G0 = gridDim.x; const int bx0 = blockIdx.x;
#define PHASE_TID() int wave = wave0, bx = bx0, G = G0; asm volatile("" : "+s"(wave), "+s"(bx), "+s"(G)); \
    const int vcu = (G % 8 == 0) ? (bx % 8) * (G / 8) + bx / 8 : bx; const int gw = vcu * NWAVES + wave, NGW = G * NWAVES; (void)gw; (void)NGW; (void)vcu; \
    unsigned ones_ = ~0u; asm volatile("" : "+s"(ones_)); int tid = wave * 64 + (int)__builtin_amdgcn_mbcnt_hi(ones_, __builtin_amdgcn_mbcnt_lo(ones_, 0u)); asm volatile("" : "+v"(tid)); const int lane = tid & 63; (void)lane
#if defined(__HIP_DEVICE_COMPILE__)
    typedef const __attribute__((address_space(4))) unsigned char* kptr_t;
#define KP() ({ kptr_t kp_ = (kptr_t)__builtin_amdgcn_kernarg_segment_ptr(); asm volatile("" : "+s"(kp_)); kp_; })
#define KLD(off) (*(const __attribute__((address_space(4))) unsigned long long*)(KP() + (off)))
#define AIN(i) ((const float*)(const __attribute__((address_space(1))) float*)KLD(8 * (i)))
#define AOUT() ((float*)(__attribute__((address_space(1))) float*)KLD(192))
#define AWS() ((unsigned char*)(__attribute__((address_space(1))) unsigned char*)KLD(200))
#else
#define AIN(i) (args.in[i])
#define AOUT() (args.out)
#define AWS() (args.ws)
#endif
    unsigned* ctl = (unsigned*)(AWS() + WS_CTL);
    if (tid0 < 64) ((LAS unsigned*)(lds + LDS_MISC))[tid0] = 0u;
    __syncthreads();
    XcdBarrier bar; bar.bar = ctl + CW_BAR; bar.x = 0; bar.st = nullptr; bar.wv = wave0;
    bar = xcd_barrier_post(ctl + CW_BAR, (volatile LAS unsigned*)(lds + LDS_MISC)); bar.wv = wave0;
#ifndef PHMASK
#define PHMASK 0xFFF
#endif
#define EN(b) ((PHMASK >> (b)) & 1)

#define IN(k) true
#define SEAM(k) do { if (IN(k) && IN((k) + 1)) { xcd_barrier(bar); if (NREP(15) > 1) xcd_barrier(bar); } } while (0)

    if (EN(0) && IN(0)) { PHASE_TID(); for (int rep = 0; rep < NREP(0); ++rep) { p0_prologue(lds, gw, NGW, wave, lane, AIN(8), AIN(13), AIN(14), AIN(19), AIN(22), AIN(2), AIN(3), AWS()); if (rep + 1 < NREP(0)) xcd_barrier(bar); } }
    SEAM(0);
    if (EN(1) && IN(1)) { PHASE_TID(); p1_mod(gw, NGW, lane, AIN(17), AIN(18), AWS(), WS_MOD); if (NREP(1) > 1) p1_mod(gw, NGW, lane, AIN(17), AIN(18), AWS(), WS_MF); }
    SEAM(1);
#define WSLOC() unsigned char* ws = AWS(); const float* xp = AIN(0); const float* xs = AIN(1); bf16* XA = (bf16*)(ws + WS_XA); bf16* H = (bf16*)(ws + WS_H); bf16* PROJ = (bf16*)(ws + WS_PROJ); bf16* U = (bf16*)(ws + WS_U); \
    float* LOGA = (float*)(ws + WS_LOGA); bf16* ON = (bf16*)(ws + WS_ON); bf16* MB = (bf16*)(ws + WS_MB); bf16* ACT = (bf16*)(ws + WS_ACT); const float* modl = (const float*)(ws + WS_MOD) + (size_t)l * NBATCH * NMOD; \
    (void)xp; (void)xs; (void)XA; (void)H; (void)PROJ; (void)U; (void)LOGA; (void)ON; (void)MB; (void)ACT; (void)modl
    for (int l = 0; l < 2; ++l) {
        const int pb = 2 + 9 * l;
        if (EN(2) && IN(pb + 0)) {
            WSLOC();
            PHASE_TID();
            for (int rep = 0; rep < NREP(2); ++rep) norm_phase<false>(lds, gw, NGW, tid, lane, l, l == 0, xp, xs, XA, AIN(15) + l * D, modl, 0, 1, H, nullptr, nullptr, nullptr, nullptr);
        }
        SEAM(pb + 0);
        if (EN(3) && IN(pb + 1)) {
            WSLOC();
            PHASE_TID();
            pg8::Gemm g{H, (const bf16*)(ws + WS_WIN) + (size_t)l * NPROJ * D, MROWS, NPROJ, D, 0, 0}; pg8::StaticOrder S; S.init(MROWS, NPROJ, G, bx);
            pg8::EpiProj E{PROJ, NPROJ, (const float*)(ws + WS_ROPE), AIN(11), (float*)(ws + WS_LOGH), l, AIN(12) + l * 3 * 256};
            if (NREP(19) > 1) glr_phase(lds, vcu, G, tid, wave, lane, H, (const bf16*)(ws + WS_WG) + (size_t)l * 2 * 16 * D, AIN(9) + l * 16 * 512, AIN(10) + l * 512, LOGA);
            glr_phase(lds, vcu, G, tid, wave, lane, H, (const bf16*)(ws + WS_WG) + (size_t)l * 2 * 16 * D, AIN(9) + l * 16 * 512, AIN(10) + l * 512, LOGA);
            if (NREP(16) > 1 && NREP(3) == 1) { pg8::EpiNull EN_{(float*)(ws + WS_PROJ)}; pg8::gemm_phase<pg8::EpiNull, pg8::StaticOrder, GALIGN, GSP2>(lds, g, S, EN_, wave); xcd_barrier(bar); }
            for (int rep = 0; rep < NREP(3); ++rep) { pg8::gemm_phase<pg8::EpiProj, pg8::StaticOrder, GALIGN, GSP2>(lds, g, S, E, wave); if (rep + 1 < NREP(3)) xcd_barrier(bar); }
        }
        SEAM(pb + 1);
        if (EN(4) && IN(pb + 2)) {
            WSLOC();
            PHASE_TID();
            for (int rep = 0; rep < NREP(4); ++rep) { rec_phase(lds, tid, wave, lane, l, bx, G, ctl + CW_QUEUE + 64 * l + 128 * rep, bar, PROJ, LOGA, (const float*)(ws + WS_LOGH), AIN(12), AIN(4), AIN(5), AIN(6), (float*)(ws + WS_DS), (float*)(ws + WS_DT), ON, AOUT()); if (rep + 1 < NREP(4)) xcd_barrier(bar); }
        }
        SEAM(pb + 2);
        if (EN(5) && IN(pb + 3)) {
            WSLOC();
            PHASE_TID();
            for (int rep = 0; rep < NREP(5); ++rep) {
                pg8::Gemm g{ON, (const bf16*)(ws + WS_WBR) + (size_t)(l * 3) * D * 1024, TP, D, 1024, (size_t)MROWS * 1024, (size_t)D * 1024}; pg8::SegOrder S; S.init(TP, D, G, bx);
                pg8::EpiBranch3 E{PROJ + MG_COL, NPROJ, MB};
                pg8::gemm_phase<pg8::EpiBranch3, pg8::SegOrder, GALIGN, GSP2>(lds, g, S, E, wave);
            }
            { __syncthreads();
              if (NREP(18) > 1) sgemm_phase<1>(lds, vcu, G, tid, wave, lane, ON, (size_t)MROWS * 1024, (const bf16*)(ws + WS_WBR) + (size_t)(l * 3) * D * 1024, (size_t)D * 1024, 1024, nullptr, nullptr, nullptr, PROJ + MG_COL, MB);
              sgemm_phase<1>(lds, vcu, G, tid, wave, lane, ON, (size_t)MROWS * 1024, (const bf16*)(ws + WS_WBR) + (size_t)(l * 3) * D * 1024, (size_t)D * 1024, 1024, nullptr, nullptr, nullptr, PROJ + MG_COL, MB); }
        }
        SEAM(pb + 3);
        if (EN(6) && IN(pb + 4)) {
            WSLOC();
            PHASE_TID();
            pg8::Gemm g{MB, (const bf16*)(ws + WS_WOUT) + (size_t)l * D * D, TP, D, D, 0, 0}; pg8::StaticOrder S; S.init(TP, D, G, bx);
            pg8::EpiResid E{l == 0 ? xp : nullptr, l == 0 ? xs : nullptr, XA, XA, modl + 2 * D};
            if (NREP(6) > 1) { pg8::EpiResid E2{l == 0 ? xp : nullptr, l == 0 ? xs : nullptr, XA, (bf16*)(ws + WS_MF), modl + 2 * D}; pg8::gemm_phase<pg8::EpiResid, pg8::StaticOrder, GALIGN, GSP2>(lds, g, S, E2, wave); }
            pg8::gemm_phase<pg8::EpiResid, pg8::StaticOrder, GALIGN, GSP2>(lds, g, S, E, wave);
            { __syncthreads();
              if (NREP(18) > 1) sgemm_phase<0>(lds, vcu, G, tid, wave, lane, MB, 0, (const bf16*)(ws + WS_WOUT) + (size_t)l * D * D, 0, D, XA, l == 0 ? xs : nullptr, modl + 2 * D, nullptr, (bf16*)(ws + WS_MF));
              sgemm_phase<0>(lds, vcu, G, tid, wave, lane, MB, 0, (const bf16*)(ws + WS_WOUT) + (size_t)l * D * D, 0, D, XA, l == 0 ? xs : nullptr, modl + 2 * D, nullptr, nullptr); }
        }
        SEAM(pb + 4);
        if (EN(7) && IN(pb + 5)) {
            WSLOC();
            PHASE_TID();
            for (int rep = 0; rep < NREP(7); ++rep) norm_phase<false>(lds, gw, NGW, tid, lane, l, 0, xp, xs, XA, AIN(16) + l * D, modl, 3, 4, H, nullptr, nullptr, nullptr, nullptr);
        }
        SEAM(pb + 5);
        if (EN(8) && IN(pb + 6)) {
            WSLOC();
            PHASE_TID();
            pg8::Gemm g{H, (const bf16*)(ws + WS_WUP) + (size_t)l * NUP * D, MROWS, NUP, D, 0, 0}; pg8::StaticOrder S; S.init(MROWS, NUP, G, bx);
            pg8::EpiUpConv E{ACT, AIN(20) + (size_t)l * 3 * NUP, AIN(21) + (size_t)l * NUP, AIN(7) + (size_t)l * 128 * 2 * NUP, (float*)(ws + WS_UH), AOUT() + O_SCONV + (size_t)l * 128 * 2 * NUP};
            for (int rep = 0; rep < NREP(8); ++rep) pg8::gemm_phase<pg8::EpiUpConv, pg8::StaticOrder, GALIGN, GSP2>(lds, g, S, E, wave);
        }
        SEAM(pb + 6);
        if (EN(9) && IN(pb + 7)) {
            WSLOC();
            PHASE_TID();
            conv_fix_phase(vcu * NWAVES * 64 + tid, G * NWAVES * 64, l, (const float*)(ws + WS_UH), AIN(20) + (size_t)l * 3 * NUP, AIN(21) + (size_t)l * NUP, ACT, AOUT());
        }
        SEAM(pb + 7);
        if (EN(10) && IN(pb + 8)) {
            WSLOC();
            PHASE_TID();
            pg8::Gemm g{ACT, (const bf16*)(ws + WS_WDN) + (size_t)l * D * DFF, TP, D, DFF, 0, 0}; pg8::StaticOrder S; S.init(TP, D, G, bx);
            pg8::EpiResid E{nullptr, nullptr, XA, XA, modl + 5 * D};
            if (NREP(10) > 1) { pg8::EpiResid E2{nullptr, nullptr, XA, (bf16*)(ws + WS_MF), modl + 5 * D}; pg8::gemm_phase<pg8::EpiResid, pg8::StaticOrder, GALIGN, GSP2>(lds, g, S, E2, wave); }
            pg8::gemm_phase<pg8::EpiResid, pg8::StaticOrder, GALIGN, GSP2>(lds, g, S, E, wave);
            { __syncthreads();
              if (NREP(18) > 1) sgemm_phase<0>(lds, vcu, G, tid, wave, lane, ACT, 0, (const bf16*)(ws + WS_WDN) + (size_t)l * D * DFF, 0, DFF, XA, nullptr, modl + 5 * D, nullptr, (bf16*)(ws + WS_MF));
              sgemm_phase<0>(lds, vcu, G, tid, wave, lane, ACT, 0, (const bf16*)(ws + WS_WDN) + (size_t)l * D * DFF, 0, DFF, XA, nullptr, modl + 5 * D, nullptr, nullptr); }
        }
        SEAM(pb + 8);
    }
    if (EN(11) && IN(20)) { PHASE_TID(); final_norm_phase(gw, NGW, lane, (const bf16*)(AWS() + WS_XA), AIN(23), AOUT()); }
#undef IN
#undef SEAM
}

extern "C" void kernel_launch(void* const* d_in, const int* in_sizes, int n_in, void* d_out, int out_size, void* d_ws, size_t ws_size, hipStream_t stream) {
    static int grid = 0;
    if (grid == 0) {
        if (n_in != 24 || ws_size < WS_END) { fprintf(stderr, "kernel_launch: unexpected n_in %d / ws_size %zu (need %zu)\n", n_in, ws_size, (size_t)WS_END); grid = -1; return; }
        int dev = 0, cus = 0, per_cu = 0;
        if (hipGetDevice(&dev) != hipSuccess || hipDeviceGetAttribute(&cus, hipDeviceAttributeMultiprocessorCount, dev) != hipSuccess) { grid = -1; return; }
        if (hipFuncSetAttribute((const void*)mega, hipFuncAttributeMaxDynamicSharedMemorySize, LDS_BYTES) != hipSuccess) { fprintf(stderr, "kernel_launch: hipFuncSetAttribute failed\n"); grid = -1; return; }
        if (hipOccupancyMaxActiveBlocksPerMultiprocessor(&per_cu, (const void*)mega, NWAVES * 64, LDS_BYTES) != hipSuccess || per_cu < 1)
            fprintf(stderr, "kernel_launch: occupancy query reports %d blocks per CU\n", per_cu);
        (void)hipGetLastError();
        grid = cus;
    }
    if (grid < 0) return;
    (void)hipMemsetAsync((char*)d_ws + WS_CTL, 0, CTL_BYTES, stream);
    Args a{};
    for (int i = 0; i < 24; ++i) a.in[i] = (const float*)d_in[i];
    a.out = (float*)d_out; a.ws = (unsigned char*)d_ws;
#if MK_ONE_LAUNCH
    a.ph_lo = 0; a.ph_hi = NPH;
    hipLaunchKernelGGL(mega, dim3(grid), dim3(NWAVES * 64), LDS_BYTES, stream, a);
#else
    for (int p = 0; p < NPH; ++p) { a.ph_lo = p; a.ph_hi = p + 1; hipLaunchKernelGGL(mega, dim3(grid), dim3(NWAVES * 64), LDS_BYTES, stream, a); }
#endif
    const hipError_t le = hipPeekAtLastError();
    if (le != hipSuccess) fprintf(stderr, "kernel_launch: launch failed: %s\n", hipGetErrorName(le));
}
```
